# Optimizing an MI355X kernel written in HIP

```python
import jax, jax.numpy as jnp
from jax import lax
import numpy as np

D_MODEL = 1024
BATCH = 2
SEQ = 8192
DEPTH = 4
DEC_BATCH = 16
DEC_SEQ = 32
PAST_LEN = 1024

CHUNK = 64
N_EVEN = (DEPTH + 1) // 2
N_ODD = DEPTH // 2
EPS = 1e-6

POOL_WINDOWS = (2, 4, 8, 16)
POOL_GROUPS = len(POOL_WINDOWS)
POOL_HIST = max(POOL_WINDOWS) - 1
W_A = D_MODEL
POOL_GDIM = W_A // POOL_GROUPS

W_B = D_MODEL
SGU_HEADS = 4
SGU_HDIM = W_B // SGU_HEADS
SGU_CHUNK = 128

EVEN_MIX = W_A + W_B
EVEN_IN = W_A + 2 * W_B + EVEN_MIX

N_HEADS_C = D_MODEL // 128
QK_NOPE = 128
QK_ROPE = 64
V_DIM = 128
KV_LORA = D_MODEL // 4
Q_LORA = 3 * D_MODEL // 8
C_MIX = N_HEADS_C * V_DIM
ODD_IN = Q_LORA + KV_LORA + QK_ROPE + C_MIX
ROPE_BASE = 10000.0
Q_BLOCK = 128
ATTN_SCALE = (QK_NOPE + QK_ROPE) ** -0.5

kernel_name = "hybrid_pool_sgu_mla_streaming_step"


def rms_norm(x, g):
    x32 = x.astype(jnp.float32)
    y = x32 * lax.rsqrt(jnp.mean(x32 * x32, axis=-1, keepdims=True) + EPS)
    return (y * g.astype(jnp.float32)).astype(x.dtype)


def layer_norm(x, g, b):
    x32 = x.astype(jnp.float32)
    mu = jnp.mean(x32, axis=-1, keepdims=True)
    xc = x32 - mu
    var = jnp.mean(xc * xc, axis=-1, keepdims=True)
    y = xc * lax.rsqrt(var + EPS) * g.astype(jnp.float32) + b.astype(jnp.float32)
    return y.astype(x.dtype)


def rope_tables(pos):
    half = QK_ROPE // 2
    freqs = ROPE_BASE ** (-jnp.arange(half, dtype=jnp.float32) / half)
    ang = pos.astype(jnp.float32)[:, None] * freqs[None, :]
    return jnp.cos(ang), jnp.sin(ang)


def apply_rope(x, cos, sin):
    half = QK_ROPE // 2
    x32 = x.astype(jnp.float32)
    x1, x2 = x32[..., :half], x32[..., half:]
    out = jnp.concatenate([x1 * cos - x2 * sin, x2 * cos + x1 * sin], axis=-1)
    return out.astype(x.dtype)


def pool_mixer(a, hist, pos0, w_pool, scale):
    B, T, W = a.shape
    P = hist.shape[1]
    full = jnp.concatenate([hist, a], axis=1).astype(jnp.float32)
    cs = jnp.concatenate([jnp.zeros((B, 1, W), jnp.float32), jnp.cumsum(full, axis=1)], axis=1)
    pos = pos0 + jnp.arange(T)
    means = []
    for g, w in enumerate(POOL_WINDOWS):
        sl = slice(g * POOL_GDIM, (g + 1) * POOL_GDIM)
        wsum = cs[:, P + 1:P + 1 + T, sl] - cs[:, P + 1 - w:P + 1 - w + T, sl]
        cnt = jnp.minimum(pos + 1, w).astype(jnp.float32)[None, :, None]
        means.append(wsum / cnt)
    d = (jnp.concatenate(means, axis=-1) - a.astype(jnp.float32)).astype(a.dtype)
    d = d.reshape(B, T, POOL_GROUPS, POOL_GDIM)
    y = jnp.einsum('btgi,gio->btgo', d, w_pool).reshape(B, T, W)
    return y * scale


def sgu_mixer(uv, ln_g, ln_b, w_s, b_s):
    uv = jax.nn.gelu(uv, approximate=False)
    u, v = uv[..., :W_B], uv[..., W_B:]
    v = layer_norm(v, ln_g, ln_b)
    B, T, W = v.shape
    L = min(T, SGU_CHUNK)
    idx = jnp.arange(L)
    mask = (idx[None, :] // CHUNK) <= (idx[:, None] // CHUNK)
    ws = jnp.where(mask[None], w_s[:, :L, :L], jnp.zeros((), w_s.dtype))
    vc = v.reshape(B, T // L, L, SGU_HEADS, SGU_HDIM)
    mixed = jnp.einsum('gij,bcjgd->bcigd', ws, vc)
    mixed = mixed + jnp.transpose(b_s[:, :L])[None, None, :, :, None]
    return u * mixed.reshape(B, T, W), v


def even_layer(x, pool_hist, pos0, g_pre, g_post, w_in, w_pool, pool_scale,
               ln_g, ln_b, w_s, b_s, w_out):
    h = rms_norm(x, g_pre)
    z = jnp.einsum('btd,de->bte', h, w_in)
    a = z[..., :W_A]
    uv = z[..., W_A:W_A + 2 * W_B]
    gate = z[..., W_A + 2 * W_B:]
    y_a = pool_mixer(a, pool_hist, pos0, w_pool, pool_scale)
    y_b, v = sgu_mixer(uv, ln_g, ln_b, w_s, b_s)
    mix = jnp.concatenate([y_a, y_b], axis=-1) * jax.nn.silu(gate)
    y = jnp.einsum('bte,ed->btd', mix, w_out)
    x = x + rms_norm(y, g_post)
    new_hist = jnp.concatenate([pool_hist, a], axis=1)[:, -POOL_HIST:]
    return x, new_hist, v


def mla_project(x, pos, g_pre, w_in, q_norm, kv_norm, w_q_up, w_kv_up):
    h = rms_norm(x, g_pre)
    z = jnp.einsum('btd,de->bte', h, w_in)
    q_c = z[..., :Q_LORA]
    kv_c = z[..., Q_LORA:Q_LORA + KV_LORA]
    k_r = z[..., Q_LORA + KV_LORA:Q_LORA + KV_LORA + QK_ROPE]
    gate = z[..., Q_LORA + KV_LORA + QK_ROPE:]
    q = jnp.einsum('btc,chd->bthd', rms_norm(q_c, q_norm), w_q_up)
    cos, sin = rope_tables(pos)
    q_rope = apply_rope(q[..., QK_NOPE:], cos[:, None, :], sin[:, None, :])
    k_rope = apply_rope(k_r, cos, sin)
    ckv = rms_norm(kv_c, kv_norm)
    q_abs = jnp.einsum('bthn,chn->bthc', q[..., :QK_NOPE], w_kv_up[..., :QK_NOPE])
    return q_abs, q_rope, ckv, k_rope, gate


def mla_attend(q_abs, q_rope, ckv, krope, q_pos, k_pos):
    s = (jnp.einsum('bqhc,bkc->bhqk', q_abs, ckv)
         + jnp.einsum('bqhr,bkr->bhqk', q_rope, krope)).astype(jnp.float32) * ATTN_SCALE
    mask = (k_pos[None, :] // CHUNK) <= (q_pos[:, None] // CHUNK)
    s = jnp.where(mask[None, None], s, -jnp.inf)
    p = jax.nn.softmax(s, axis=-1).astype(ckv.dtype)
    return jnp.einsum('bhqk,bkc->bqhc', p, ckv)


def mla_attend_blocked(q_abs, q_rope, ckv, krope):
    B, T, H, C = q_abs.shape
    nb = T // Q_BLOCK
    k_pos = jnp.arange(T)
    qa = jnp.swapaxes(q_abs.reshape(B, nb, Q_BLOCK, H, C), 0, 1)
    qr = jnp.swapaxes(q_rope.reshape(B, nb, Q_BLOCK, H, QK_ROPE), 0, 1)
    starts = jnp.arange(nb) * Q_BLOCK

    def one_block(args):
        qa_b, qr_b, s0 = args
        return mla_attend(qa_b, qr_b, ckv, krope, s0 + jnp.arange(Q_BLOCK), k_pos)

    o = lax.map(one_block, (qa, qr, starts))
    return jnp.swapaxes(o, 0, 1).reshape(B, T, H, C)


def mla_output(o_lat, gate, w_kv_up, w_o):
    B, T = o_lat.shape[:2]
    o = jnp.einsum('bthc,chv->bthv', o_lat, w_kv_up[..., QK_NOPE:]).reshape(B, T, C_MIX)
    return jnp.einsum('bte,ed->btd', o * jax.nn.silu(gate), w_o)


def setup_inputs(seed: int = 0) -> dict:
    key = jax.random.key(seed)
    ks = jax.random.split(key, 24)
    f32 = jnp.float32

    def nrm(k, shape, scale):
        return scale * jax.random.normal(k, shape, f32)

    return {
        "x_prompt": nrm(ks[0], (BATCH, SEQ, D_MODEL), 1.0),
        "x_sample": nrm(ks[1], (DEC_BATCH, DEC_SEQ, D_MODEL), 1.0),
        "cache_pool": nrm(ks[2], (N_EVEN, DEC_BATCH, POOL_HIST, W_A), 1.0),
        "cache_ckv": nrm(ks[3], (N_ODD, DEC_BATCH, PAST_LEN, KV_LORA), 1.0),
        "cache_krope": nrm(ks[4], (N_ODD, DEC_BATCH, PAST_LEN, QK_ROPE), 1.0),
        "norm_pre": 1.0 + nrm(ks[5], (DEPTH, D_MODEL), 0.05),
        "norm_post": 1.0 + nrm(ks[6], (DEPTH, D_MODEL), 0.05),
        "w_in_even": nrm(ks[7], (N_EVEN, D_MODEL, EVEN_IN), D_MODEL ** -0.5),
        "w_pool": nrm(ks[8], (N_EVEN, POOL_GROUPS, POOL_GDIM, POOL_GDIM), POOL_GDIM ** -0.5),
        "pool_scale": 1.0 + nrm(ks[9], (N_EVEN, W_A), 0.1),
        "sgu_ln_g": 1.0 + nrm(ks[10], (N_EVEN, W_B), 0.05),
        "sgu_ln_b": nrm(ks[11], (N_EVEN, W_B), 0.02),
        "w_spatial": nrm(ks[12], (N_EVEN, SGU_HEADS, SGU_CHUNK, SGU_CHUNK), 0.5 * SGU_CHUNK ** -0.5),
        "b_spatial": 1.0 + nrm(ks[13], (N_EVEN, SGU_HEADS, SGU_CHUNK), 0.02),
        "w_out_even": nrm(ks[14], (N_EVEN, EVEN_MIX, D_MODEL), EVEN_MIX ** -0.5),
        "w_in_odd": nrm(ks[15], (N_ODD, D_MODEL, ODD_IN), D_MODEL ** -0.5),
        "q_norm": 1.0 + nrm(ks[16], (N_ODD, Q_LORA), 0.05),
        "kv_norm": 1.0 + nrm(ks[17], (N_ODD, KV_LORA), 0.05),
        "w_q_up": nrm(ks[18], (N_ODD, Q_LORA, N_HEADS_C, QK_NOPE + QK_ROPE), Q_LORA ** -0.5),
        "w_kv_up": nrm(ks[19], (N_ODD, KV_LORA, N_HEADS_C, QK_NOPE + V_DIM), KV_LORA ** -0.5),
        "w_o": nrm(ks[20], (N_ODD, C_MIX, D_MODEL), C_MIX ** -0.5),
    }


def reference(x_prompt, x_sample, cache_pool, cache_ckv, cache_krope, norm_pre, norm_post,
              w_in_even, w_pool, pool_scale, sgu_ln_g, sgu_ln_b, w_spatial, b_spatial, w_out_even,
              w_in_odd, q_norm, kv_norm, w_q_up, w_kv_up, w_o):
    past = cache_ckv.shape[2]
    T = x_prompt.shape[1]
    S = x_sample.shape[1]
    pos_p = jnp.arange(T)
    pos_s = past + jnp.arange(S)
    k_pos_s = jnp.arange(past + S)
    xp, xs = x_prompt, x_sample
    pool_p, pool_s, sgu_s = [], [], []
    ckv_p, kr_p, ckv_s, kr_s = [], [], [], []
    for l in range(DEPTH):
        if l % 2 == 0:
            e = l // 2
            ew = (norm_pre[l], norm_post[l], w_in_even[e], w_pool[e], pool_scale[e],
                  sgu_ln_g[e], sgu_ln_b[e], w_spatial[e], b_spatial[e], w_out_even[e])
            zero_hist = jnp.zeros((xp.shape[0], POOL_HIST, W_A), xp.dtype)
            xp, hp, _ = even_layer(xp, zero_hist, 0, *ew)
            xs, hs, vs = even_layer(xs, cache_pool[e], past, *ew)
            pool_p.append(hp)
            pool_s.append(hs)
            sgu_s.append(vs)
        else:
            o = l // 2
            qa, qr, ckv, kr, g = mla_project(xp, pos_p, norm_pre[l], w_in_odd[o], q_norm[o],
                                             kv_norm[o], w_q_up[o], w_kv_up[o])
            ol = mla_attend_blocked(qa, qr, ckv, kr)
            xp = xp + rms_norm(mla_output(ol, g, w_kv_up[o], w_o[o]), norm_post[l])
            ckv_p.append(ckv)
            kr_p.append(kr)
            qa, qr, ckv, kr, g = mla_project(xs, pos_s, norm_pre[l], w_in_odd[o], q_norm[o],
                                             kv_norm[o], w_q_up[o], w_kv_up[o])
            ckv_all = jnp.concatenate([cache_ckv[o], ckv], axis=1)
            kr_all = jnp.concatenate([cache_krope[o], kr], axis=1)
            ol = mla_attend(qa, qr, ckv_all, kr_all, pos_s, k_pos_s)
            xs = xs + rms_norm(mla_output(ol, g, w_kv_up[o], w_o[o]), norm_post[l])
            ckv_s.append(ckv)
            kr_s.append(kr)
    return (xp, xs, jnp.stack(pool_p), jnp.stack(pool_s), jnp.stack(sgu_s),
            jnp.stack(ckv_p), jnp.stack(kr_p), jnp.stack(ckv_s), jnp.stack(kr_s))
```

```cpp
#include <hip/hip_runtime.h>
#include <hip/hip_cooperative_groups.h>
#include <cstdio>
namespace cg = cooperative_groups;

typedef unsigned short u16;
using bf16x8 = __attribute__((ext_vector_type(8))) short;
using f32x4 = __attribute__((ext_vector_type(4))) float;
using f32x16 = __attribute__((ext_vector_type(16))) float;
using u32x4 = __attribute__((ext_vector_type(4))) unsigned;
using u32x2 = __attribute__((ext_vector_type(2))) unsigned;
#define DI __device__ __forceinline__

#ifndef USE_COOP
#define USE_COOP 0
#endif

constexpr int M_TOK = 16896;
constexpr int M_PROMPT = 16384;
constexpr int KSTR_S = 1152;
constexpr int KVR = 16384 + 16 * KSTR_S;
constexpr int NPHASE = 25;
constexpr float QSCALE = 0.07216878364870322f * 1.4426950408889634f;

constexpr size_t OFF_W = 0;
constexpr size_t OFF_H = 16777216;
constexpr size_t SZ_H = 34603008;
constexpr size_t OFF_A = OFF_H + SZ_H;
constexpr size_t OFF_UV = OFF_A + SZ_H;
constexpr size_t OFF_GATE = OFF_UV + 69206016;
constexpr size_t OFF_VTE = OFF_GATE + 69206016;
constexpr size_t OFF_CKVB = OFF_H;
constexpr size_t OFF_QN = OFF_H + 17825792;
constexpr size_t OFF_VTO = OFF_QN;
constexpr size_t OFF_ZQ = OFF_VTO + 71303168;
constexpr size_t OFF_GO = OFF_ZQ + 51904512;
constexpr size_t OFF_KN = OFF_GO + 34603008;
constexpr size_t WS_NEED = OFF_KN + 71303168;
static_assert(WS_NEED <= 268435456, "ws");
static_assert(OFF_VTE + 37748736 <= 268435456, "ws");
constexpr size_t WE_IN = 0, WE_OUT = 5242880, WE_POOL = 7340032, WE_WS = 7602176;
constexpr size_t WO_IN = 0, WO_Q = 1835008, WO_KV = 2424832, WO_O = 2949120;
constexpr size_t OFFB_ROPE = 7995392, OFFB_KROPEB = 10092544;
constexpr size_t OUT_SPP = 17301504, OUT_SPS = 17362944, OUT_SGUV = 17854464, OUT_CKVP = 18903040,
                 OUT_KRP = 27291648, OUT_CKVS = 29388800, OUT_KRS = 29650944;

struct Params {
  const float *x_prompt, *x_sample, *cache_pool, *cache_ckv, *cache_krope, *norm_pre, *norm_post,
      *w_in_even, *w_pool, *pool_scale, *sgu_ln_g, *sgu_ln_b, *w_spatial, *b_spatial, *w_out_even,
      *w_in_odd, *q_norm, *kv_norm, *w_q_up, *w_kv_up, *w_o;
  float* out;
  char* ws;
};

DI u16 f2bf(float x) { unsigned u = __float_as_uint(x); u += 0x7fffu + ((u >> 16) & 1u); return (u16)(u >> 16); }
DI float bf2f(u16 v) { return __uint_as_float(((unsigned)v) << 16); }
DI unsigned pk2(float a, float b) { return (unsigned)f2bf(a) | ((unsigned)f2bf(b) << 16); }
DI float bflo(unsigned u) { return __uint_as_float(u << 16); }
DI float bfhi(unsigned u) { return __uint_as_float(u & 0xffff0000u); }
DI float wave_sum(float v) {
#pragma unroll
  for (int o = 32; o; o >>= 1) v += __shfl_xor(v, o, 64);
  return v;
}
DI float gelu_f(float x) { return 0.5f * x * (1.f + erff(x * 0.70710678118654752f)); }
DI float silu_f(float x) { return x / (1.f + __expf(-x)); }
DI int tok_pos(int m) { return m < M_PROMPT ? (m & 8191) : 1024 + ((m - M_PROMPT) & 31); }

template <class Epi>
DI void gemm_tile(const u16* __restrict__ X, long ldx, const u16* __restrict__ W, long ldw, int K, char* smem,
                  int m0, int n0, const Epi& epi) {
  const int tid = threadIdx.x, lane = tid & 63, wave = tid >> 6;
  const int wm = wave & 1, wn = wave >> 1;
  const int lr = lane & 15, g = lane >> 4;
  const int ldr = tid >> 3, ldc = tid & 7;
  const int woff = ldr * 128 + ((ldc ^ ((ldr >> 1) & 7)) << 4);
  const int rsw = (lr >> 1) & 7;
  f32x4 acc[4][4];
#pragma unroll
  for (int a = 0; a < 4; ++a)
#pragma unroll
    for (int b = 0; b < 4; ++b) acc[a][b] = (f32x4){0.f, 0.f, 0.f, 0.f};
  const u16* xp = X + (long)ldr * ldx + ldc * 8;
  const u16* wp = W + (long)ldr * ldw + ldc * 8;
  u32x4 rx[4], rw[4];
#pragma unroll
  for (int i = 0; i < 4; ++i) {
    rx[i] = *(const u32x4*)(xp + (long)(32 * i) * ldx);
    rw[i] = *(const u32x4*)(wp + (long)(32 * i) * ldw);
  }
#pragma unroll
  for (int i = 0; i < 4; ++i) {
    *(u32x4*)(smem + woff + i * 4096) = rx[i];
    *(u32x4*)(smem + 16384 + woff + i * 4096) = rw[i];
  }
  __syncthreads();
  const int nk = K >> 6;
  for (int kt = 0; kt < nk; ++kt) {
    char* cur = smem + (kt & 1) * 32768;
    char* nxt = smem + ((kt & 1) ^ 1) * 32768;
    const bool more = (kt + 1 < nk);
    if (more) {
      xp += 64; wp += 64;
#pragma unroll
      for (int i = 0; i < 4; ++i) {
        rx[i] = *(const u32x4*)(xp + (long)(32 * i) * ldx);
        rw[i] = *(const u32x4*)(wp + (long)(32 * i) * ldw);
      }
    }
#pragma unroll
    for (int ks = 0; ks < 2; ++ks) {
      bf16x8 xf[4], wf[4];
      const int ch = ((ks * 4 + g) ^ rsw) << 4;
#pragma unroll
      for (int i = 0; i < 4; ++i) {
        xf[i] = *(const bf16x8*)(cur + (wm * 64 + i * 16 + lr) * 128 + ch);
        wf[i] = *(const bf16x8*)(cur + 16384 + (wn * 64 + i * 16 + lr) * 128 + ch);
      }
#pragma unroll
      for (int nt = 0; nt < 4; ++nt)
#pragma unroll
        for (int mt = 0; mt < 4; ++mt)
          acc[nt][mt] = __builtin_amdgcn_mfma_f32_16x16x32_bf16(wf[nt], xf[mt], acc[nt][mt], 0, 0, 0);
    }
    if (more) {
#pragma unroll
      for (int i = 0; i < 4; ++i) {
        *(u32x4*)(nxt + woff + i * 4096) = rx[i];
        *(u32x4*)(nxt + 16384 + woff + i * 4096) = rw[i];
      }
    }
    __syncthreads();
  }
  epi.run(acc, m0 + wm * 64 + lr, n0 + wn * 64 + 4 * g);
}

DI void st_bf4(u16* p, float a, float b, float c, float d) { *(uint2*)p = make_uint2(pk2(a, b), pk2(c, d)); }

struct EpiE1 {
  u16 *abuf, *uvbuf, *gatebuf; float *spp, *sps;
  DI void run(f32x4 (&acc)[4][4], int mb, int nb) const {
#pragma unroll
    for (int nt = 0; nt < 4; ++nt) {
      const int n = nb + nt * 16;
#pragma unroll
      for (int mt = 0; mt < 4; ++mt) {
        const int m = mb + mt * 16;
        f32x4 v = acc[nt][mt];
        if (n < 1024) {
          st_bf4(abuf + (size_t)m * 1024 + n, v[0], v[1], v[2], v[3]);
          float* dst = nullptr;
          if (m < M_PROMPT) { int t = m & 8191; if (t >= 8177) dst = spp + ((size_t)((m >> 13) * 15 + (t - 8177))) * 1024 + n; }
          else { int r = m - M_PROMPT; int s = r & 31; if (s >= 17) dst = sps + ((size_t)((r >> 5) * 15 + (s - 17))) * 1024 + n; }
          if (dst) *(float4*)dst = make_float4(v[0], v[1], v[2], v[3]);
        } else if (n < 3072) {
          st_bf4(uvbuf + (size_t)m * 2048 + (n - 1024), gelu_f(v[0]), gelu_f(v[1]), gelu_f(v[2]), gelu_f(v[3]));
        } else {
          st_bf4(gatebuf + (size_t)m * 2048 + (n - 3072), silu_f(v[0]), silu_f(v[1]), silu_f(v[2]), silu_f(v[3]));
        }
      }
    }
  }
};

struct EpiPool {
  const float* scale; u16* mix; int g;
  DI void run(f32x4 (&acc)[4][4], int mb, int nb) const {
#pragma unroll
    for (int nt = 0; nt < 4; ++nt) {
      const int ch = g * 256 + nb + nt * 16;
      const float4 sc = *(const float4*)(scale + ch);
#pragma unroll
      for (int mt = 0; mt < 4; ++mt) {
        const int m = mb + mt * 16;
        u16* q = mix + (size_t)m * 2048 + ch;
        const uint2 gt = *(const uint2*)q;
        f32x4 v = acc[nt][mt];
        st_bf4(q, v[0] * sc.x * bflo(gt.x), v[1] * sc.y * bfhi(gt.x), v[2] * sc.z * bflo(gt.y), v[3] * sc.w * bfhi(gt.y));
      }
    }
  }
};

struct EpiSgu {
  const float* bs; const u16* uv; u16* mix; int g, rowbase, nvalid;
  DI void run(f32x4 (&acc)[4][4], int mb, int nb) const {
#pragma unroll
    for (int mt = 0; mt < 4; ++mt) {
      const int i = mb + mt * 16;
      if (i < nvalid) {
        const float bias = bs[i];
        const size_t row = (size_t)(rowbase + i);
#pragma unroll
        for (int nt = 0; nt < 4; ++nt) {
          const int ch = g * 256 + nb + nt * 16;
          const uint2 uu = *(const uint2*)(uv + row * 2048 + ch);
          u16* q = mix + row * 2048 + 1024 + ch;
          const uint2 gt = *(const uint2*)q;
          f32x4 v = acc[nt][mt];
          st_bf4(q, (v[0] + bias) * bflo(uu.x) * bflo(gt.x), (v[1] + bias) * bfhi(uu.x) * bfhi(gt.x),
                 (v[2] + bias) * bflo(uu.y) * bflo(gt.y), (v[3] + bias) * bfhi(uu.y) * bfhi(gt.y));
        }
      }
    }
  }
};

struct EpiF32 {
  float* C; long ldc;
  DI void run(f32x4 (&acc)[4][4], int mb, int nb) const {
#pragma unroll
    for (int nt = 0; nt < 4; ++nt)
#pragma unroll
      for (int mt = 0; mt < 4; ++mt) {
        f32x4 v = acc[nt][mt];
        *(float4*)(C + (size_t)(mb + mt * 16) * ldc + nb + nt * 16) = make_float4(v[0], v[1], v[2], v[3]);
      }
  }
};

struct EpiBF16 {
  u16* C; long ldc;
  DI void run(f32x4 (&acc)[4][4], int mb, int nb) const {
#pragma unroll
    for (int nt = 0; nt < 4; ++nt)
#pragma unroll
      for (int mt = 0; mt < 4; ++mt) {
        f32x4 v = acc[nt][mt];
        st_bf4(C + (size_t)(mb + mt * 16) * ldc + nb + nt * 16, v[0], v[1], v[2], v[3]);
      }
  }
};

struct EpiO1 {
  float* zq; u16* gate;
  DI void run(f32x4 (&acc)[4][4], int mb, int nb) const {
#pragma unroll
    for (int nt = 0; nt < 4; ++nt) {
      const int n = nb + nt * 16;
#pragma unroll
      for (int mt = 0; mt < 4; ++mt) {
        const int m = mb + mt * 16;
        f32x4 v = acc[nt][mt];
        if (n < 704) *(float4*)(zq + (size_t)m * 704 + n) = make_float4(v[0], v[1], v[2], v[3]);
        else if (n < 1728) st_bf4(gate + (size_t)m * 1024 + (n - 704), silu_f(v[0]), silu_f(v[1]), silu_f(v[2]), silu_f(v[3]));
      }
    }
  }
};

struct EpiQup {
  const float2* rope; u16* q;
  DI void run(f32x4 (&acc)[4][4], int mb, int nb) const {
    const int g4 = nb & 15;
    const int grp = (nb - g4) >> 6;
    if ((grp % 3) == 2) {
#pragma unroll
      for (int mt = 0; mt < 4; ++mt) {
        const int pos = tok_pos(mb + mt * 16);
#pragma unroll
        for (int nt = 0; nt < 2; ++nt)
#pragma unroll
          for (int j = 0; j < 4; ++j) {
            const float2 cs = rope[pos * 32 + nt * 16 + g4 + j];
            const float x1 = acc[nt][mt][j], x2 = acc[nt + 2][mt][j];
            acc[nt][mt][j] = x1 * cs.x - x2 * cs.y;
            acc[nt + 2][mt][j] = x2 * cs.x + x1 * cs.y;
          }
      }
    }
#pragma unroll
    for (int nt = 0; nt < 4; ++nt)
#pragma unroll
      for (int mt = 0; mt < 4; ++mt) {
        f32x4 v = acc[nt][mt];
        st_bf4(q + (size_t)(mb + mt * 16) * 1536 + nb + nt * 16, v[0] * QSCALE, v[1] * QSCALE, v[2] * QSCALE, v[3] * QSCALE);
      }
  }
};

DI void tconv_tile(const float* __restrict__ src, long lds, int cvalid, u16* __restrict__ dst, long ldd, int r0, int c0, char* smem) {
  float (*T)[65] = (float (*)[65])smem;
  const int tid = threadIdx.x;
  __syncthreads();
  const int lr = tid >> 4, lc = (tid & 15) * 4;
#pragma unroll
  for (int i = 0; i < 4; ++i) {
    const int r = lr + 16 * i;
    float4 v = make_float4(0.f, 0.f, 0.f, 0.f);
    if (c0 + lc < cvalid) v = *(const float4*)(src + (long)(r0 + r) * lds + c0 + lc);
    T[r][lc] = v.x; T[r][lc + 1] = v.y; T[r][lc + 2] = v.z; T[r][lc + 3] = v.w;
  }
  __syncthreads();
  const int oc = tid >> 2, seg = (tid & 3) * 16;
  unsigned pk[8];
#pragma unroll
  for (int k = 0; k < 8; ++k) pk[k] = pk2(T[seg + 2 * k][oc], T[seg + 2 * k + 1][oc]);
  uint4* d = (uint4*)(dst + (long)(c0 + oc) * ldd + r0 + seg);
  d[0] = make_uint4(pk[0], pk[1], pk[2], pk[3]);
  d[1] = make_uint4(pk[4], pk[5], pk[6], pk[7]);
}

DI void convert_weights(const Params& p, int layer, char* smem) {
  u16* W = (u16*)(p.ws + OFF_W);
  const int tid = threadIdx.x;
  if ((layer & 1) == 0) {
    const int e = layer >> 1;
    for (int t = blockIdx.x; t < 1920; t += gridDim.x) {
      if (t < 1280) {
        tconv_tile(p.w_in_even + (size_t)e * 1024 * 5120, 5120, 5120, W + WE_IN, 1024, (t / 80) * 64, (t % 80) * 64, smem);
      } else if (t < 1792) {
        const int u = t - 1280;
        tconv_tile(p.w_out_even + (size_t)e * 2048 * 1024, 1024, 1024, W + WE_OUT, 2048, (u >> 4) * 64, (u & 15) * 64, smem);
      } else if (t < 1856) {
        const int u = t - 1792, g = u >> 4, v = u & 15;
        tconv_tile(p.w_pool + (size_t)(e * 4 + g) * 65536, 256, 256, W + WE_POOL + (size_t)g * 65536, 256, (v >> 2) * 64, (v & 3) * 64, smem);
      } else {
        const int idx = (t - 1856) * 1024 + tid * 4;
        const int i = (idx >> 7) & 127, j = idx & 127;
        float4 v = *(const float4*)(p.w_spatial + (size_t)e * 65536 + idx);
        if ((j >> 6) > (i >> 6)) v = make_float4(0.f, 0.f, 0.f, 0.f);
        st_bf4(W + WE_WS + idx, v.x, v.y, v.z, v.w);
      }
    }
  } else {
    const int o = layer >> 1;
    float2* rope = (float2*)(p.ws + OFFB_ROPE);
    for (int t = blockIdx.x; t < 2000; t += gridDim.x) {
      if (t < 448) {
        tconv_tile(p.w_in_odd + (size_t)o * 1024 * 1728, 1728, 1728, W + WO_IN, 1024, (t / 28) * 64, (t % 28) * 64, smem);
      } else if (t < 592) {
        const int u = t - 448;
        tconv_tile(p.w_q_up + (size_t)o * 384 * 1536, 1536, 1536, W + WO_Q, 384, (u / 24) * 64, (u % 24) * 64, smem);
      } else if (t < 720) {
        const int u = t - 592;
        tconv_tile(p.w_kv_up + (size_t)o * 256 * 2048, 2048, 2048, W + WO_KV, 256, (u >> 5) * 64, (u & 31) * 64, smem);
      } else if (t < 976) {
        const int u = t - 720;
        tconv_tile(p.w_o + (size_t)o * 1024 * 1024, 1024, 1024, W + WO_O, 1024, (u >> 4) * 64, (u & 15) * 64, smem);
      } else {
        const int idx = (t - 976) * 256 + tid;
        const int pos = idx >> 5, i = idx & 31;
        const float freq = exp2f(-(float)i * (13.287712379549449f / 32.f));
        const float ang = (float)pos * freq;
        float s, c;
        sincosf(ang, &s, &c);
        rope[idx] = make_float2(c, s);
      }
    }
  }
}

DI void prenorm0(const Params& p) {
  const int lane = threadIdx.x & 63;
  u16* h = (u16*)(p.ws + OFF_H);
  for (int r = blockIdx.x * 4 + (threadIdx.x >> 6); r < M_TOK; r += gridDim.x * 4) {
    const float* x = r < M_PROMPT ? p.x_prompt + (size_t)r * 1024 : p.x_sample + (size_t)(r - M_PROMPT) * 1024;
    float4 v[4]; float ss = 0.f;
#pragma unroll
    for (int i = 0; i < 4; ++i) { v[i] = *(const float4*)(x + lane * 4 + 256 * i); ss += v[i].x * v[i].x + v[i].y * v[i].y + v[i].z * v[i].z + v[i].w * v[i].w; }
    ss = wave_sum(ss);
    const float rs = rsqrtf(ss * (1.f / 1024.f) + 1e-6f);
#pragma unroll
    for (int i = 0; i < 4; ++i) {
      const float4 gg = *(const float4*)(p.norm_pre + lane * 4 + 256 * i);
      st_bf4(h + (size_t)r * 1024 + lane * 4 + 256 * i, v[i].x * rs * gg.x, v[i].y * rs * gg.y, v[i].z * rs * gg.z, v[i].w * rs * gg.w);
    }
  }
}

DI void resid_norm(const Params& p, int layer, const float* __restrict__ y) {
  const int lane = threadIdx.x & 63;
  u16* h = (u16*)(p.ws + OFF_H);
  const float* gpost = p.norm_post + layer * 1024;
  const float* gpre = p.norm_pre + (layer + 1) * 1024;
  for (int r = blockIdx.x * 4 + (threadIdx.x >> 6); r < M_TOK; r += gridDim.x * 4) {
    const float* x;
    if (layer == 0) x = r < M_PROMPT ? p.x_prompt + (size_t)r * 1024 : p.x_sample + (size_t)(r - M_PROMPT) * 1024;
    else x = p.out + (size_t)r * 1024;
    float4 yv[4], xv[4]; float ss = 0.f;
#pragma unroll
    for (int i = 0; i < 4; ++i) {
      yv[i] = *(const float4*)(y + (size_t)r * 1024 + lane * 4 + 256 * i);
      xv[i] = *(const float4*)(x + lane * 4 + 256 * i);
      ss += yv[i].x * yv[i].x + yv[i].y * yv[i].y + yv[i].z * yv[i].z + yv[i].w * yv[i].w;
    }
    ss = wave_sum(ss);
    const float rs = rsqrtf(ss * (1.f / 1024.f) + 1e-6f);
    float ss2 = 0.f;
#pragma unroll
    for (int i = 0; i < 4; ++i) {
      const float4 gg = *(const float4*)(gpost + lane * 4 + 256 * i);
      xv[i].x += yv[i].x * rs * gg.x; xv[i].y += yv[i].y * rs * gg.y; xv[i].z += yv[i].z * rs * gg.z; xv[i].w += yv[i].w * rs * gg.w;
      *(float4*)(p.out + (size_t)r * 1024 + lane * 4 + 256 * i) = xv[i];
      ss2 += xv[i].x * xv[i].x + xv[i].y * xv[i].y + xv[i].z * xv[i].z + xv[i].w * xv[i].w;
    }
    if (layer < 3) {
      ss2 = wave_sum(ss2);
      const float rs2 = rsqrtf(ss2 * (1.f / 1024.f) + 1e-6f);
#pragma unroll
      for (int i = 0; i < 4; ++i) {
        const float4 gg = *(const float4*)(gpre + lane * 4 + 256 * i);
        st_bf4(h + (size_t)r * 1024 + lane * 4 + 256 * i, xv[i].x * rs2 * gg.x, xv[i].y * rs2 * gg.y, xv[i].z * rs2 * gg.z, xv[i].w * rs2 * gg.w);
      }
    }
  }
}

DI void sgu_ln_items(const Params& p, int e, char* smem) {
  const int tid = threadIdx.x, lane = tid & 63, wave = tid >> 6;
  const u16* uv = (const u16*)(p.ws + OFF_UV);
  u16* vT = (u16*)(p.ws + OFF_VTE);
  float2* st = (float2*)smem;
  u16* T = (u16*)(smem + 1024);
  const float* lg = p.sgu_ln_g + e * 1024;
  const float* lb = p.sgu_ln_b + e * 1024;
  for (int c = blockIdx.x; c < 144; c += gridDim.x) {
    const int rowbase = c < 128 ? c * 128 : M_PROMPT + (c - 128) * 32;
    const int nvalid = c < 128 ? 128 : 32;
    __syncthreads();
    for (int ii = 0; ii < 32; ++ii) {
      const int i = wave * 32 + ii;
      float mu = 0.f, rstd = 0.f;
      if (i < nvalid) {
        const u16* src = uv + (size_t)(rowbase + i) * 2048 + 1024 + lane * 8;
        float s = 0.f, s2 = 0.f;
#pragma unroll
        for (int j = 0; j < 2; ++j) {
          const uint4 q = *(const uint4*)(src + 512 * j);
          const float f[8] = {bflo(q.x), bfhi(q.x), bflo(q.y), bfhi(q.y), bflo(q.z), bfhi(q.z), bflo(q.w), bfhi(q.w)};
#pragma unroll
          for (int k = 0; k < 8; ++k) { s += f[k]; s2 += f[k] * f[k]; }
        }
        s = wave_sum(s); s2 = wave_sum(s2);
        mu = s * (1.f / 1024.f);
        const float var = fmaxf(s2 * (1.f / 1024.f) - mu * mu, 0.f);
        rstd = rsqrtf(var + 1e-6f);
      }
      if (lane == 0) st[i] = make_float2(mu, rstd);
    }
    __syncthreads();
    const int rr = tid >> 3, cc = tid & 7;
    for (int slab = 0; slab < 16; ++slab) {
      const int ch = slab * 64 + cc * 8;
      const float4 g0 = *(const float4*)(lg + ch), g1 = *(const float4*)(lg + ch + 4);
      const float4 b0 = *(const float4*)(lb + ch), b1 = *(const float4*)(lb + ch + 4);
#pragma unroll
      for (int i4 = 0; i4 < 4; ++i4) {
        const int i = rr + 32 * i4;
        float o[8];
        if (i < nvalid) {
          const uint4 q = *(const uint4*)(uv + (size_t)(rowbase + i) * 2048 + 1024 + ch);
          const float2 ms = st[i];
          o[0] = (bflo(q.x) - ms.x) * ms.y * g0.x + b0.x; o[1] = (bfhi(q.x) - ms.x) * ms.y * g0.y + b0.y;
          o[2] = (bflo(q.y) - ms.x) * ms.y * g0.z + b0.z; o[3] = (bfhi(q.y) - ms.x) * ms.y * g0.w + b0.w;
          o[4] = (bflo(q.z) - ms.x) * ms.y * g1.x + b1.x; o[5] = (bfhi(q.z) - ms.x) * ms.y * g1.y + b1.y;
          o[6] = (bflo(q.w) - ms.x) * ms.y * g1.z + b1.z; o[7] = (bfhi(q.w) - ms.x) * ms.y * g1.w + b1.w;
          if (c >= 128) {
            float* dst = p.out + OUT_SGUV + ((size_t)(e * 16 + (c - 128)) * 32 + i) * 1024 + ch;
            *(float4*)dst = make_float4(o[0], o[1], o[2], o[3]);
            *(float4*)(dst + 4) = make_float4(o[4], o[5], o[6], o[7]);
          }
        } else {
#pragma unroll
          for (int k = 0; k < 8; ++k) o[k] = 0.f;
        }
#pragma unroll
        for (int k = 0; k < 8; ++k) T[(cc * 8 + k) * 136 + i] = f2bf(o[k]);
      }
      __syncthreads();
#pragma unroll
      for (int j = 0; j < 4; ++j) {
        const int idx = tid + 256 * j;
        const int chl = idx >> 4, pc = idx & 15;
        const uint4 q = *(const uint4*)(T + chl * 136 + pc * 8);
        *(uint4*)(vT + ((size_t)c * 1024 + slab * 64 + chl) * 128 + pc * 8) = q;
      }
      __syncthreads();
    }
  }
}

DI void pool_d_items(const Params& p, int e) {
  const u16* a = (const u16*)(p.ws + OFF_A);
  u16* d = (u16*)(p.ws + OFF_H);
  const float* hist = p.cache_pool + (size_t)e * 16 * 15 * 1024;
  for (int idx = blockIdx.x * 256 + threadIdx.x; idx < M_TOK * 128; idx += gridDim.x * 256) {
    const int r = idx >> 7, ch0 = (idx & 127) * 8;
    const int w = 2 << (ch0 >> 8);
    float acc[8];
#pragma unroll
    for (int k = 0; k < 8; ++k) acc[k] = 0.f;
    const uint4 self = *(const uint4*)(a + (size_t)r * 1024 + ch0);
    float cnt;
    if (r < M_PROMPT) {
      const int t = r & 8191;
      const int nw = min(t + 1, w);
      cnt = (float)nw;
      for (int i = 0; i < nw; ++i) {
        const uint4 q = *(const uint4*)(a + (size_t)(r - i) * 1024 + ch0);
        acc[0] += bflo(q.x); acc[1] += bfhi(q.x); acc[2] += bflo(q.y); acc[3] += bfhi(q.y);
        acc[4] += bflo(q.z); acc[5] += bfhi(q.z); acc[6] += bflo(q.w); acc[7] += bfhi(q.w);
      }
    } else {
      const int rr = r - M_PROMPT, b = rr >> 5, s = rr & 31;
      cnt = (float)w;
      for (int i = 0; i < w; ++i) {
        const int sp = s - i;
        if (sp >= 0) {
          const uint4 q = *(const uint4*)(a + (size_t)(r - i) * 1024 + ch0);
          acc[0] += bflo(q.x); acc[1] += bfhi(q.x); acc[2] += bflo(q.y); acc[3] += bfhi(q.y);
          acc[4] += bflo(q.z); acc[5] += bfhi(q.z); acc[6] += bflo(q.w); acc[7] += bfhi(q.w);
        } else {
          const float* hp = hist + ((size_t)b * 15 + (15 + sp)) * 1024 + ch0;
          const float4 h0 = *(const float4*)hp, h1 = *(const float4*)(hp + 4);
          acc[0] += h0.x; acc[1] += h0.y; acc[2] += h0.z; acc[3] += h0.w;
          acc[4] += h1.x; acc[5] += h1.y; acc[6] += h1.z; acc[7] += h1.w;
        }
      }
    }
    const float inv = 1.f / cnt;
    uint4 o;
    o.x = pk2(acc[0] * inv - bflo(self.x), acc[1] * inv - bfhi(self.x));
    o.y = pk2(acc[2] * inv - bflo(self.y), acc[3] * inv - bfhi(self.y));
    o.z = pk2(acc[4] * inv - bflo(self.z), acc[5] * inv - bfhi(self.z));
    o.w = pk2(acc[6] * inv - bflo(self.w), acc[7] * inv - bfhi(self.w));
    *(uint4*)(d + (size_t)r * 1024 + ch0) = o;
  }
}

DI void odd_rows(const Params& p, int o) {
  const int tid = threadIdx.x, lane = tid & 63;
  const float* zq = (const float*)(p.ws + OFF_ZQ);
  u16* qn = (u16*)(p.ws + OFF_QN);
  u16* ckvb = (u16*)(p.ws + OFF_CKVB);
  u16* krb = (u16*)(p.ws + OFFB_KROPEB);
  const float2* rope = (const float2*)(p.ws + OFFB_ROPE);
  const float* qnw = p.q_norm + o * 384;
  const float* kvw = p.kv_norm + o * 256;
  for (int r = blockIdx.x * 4 + (tid >> 6); r < M_TOK; r += gridDim.x * 4) {
    const float* z = zq + (size_t)r * 704;
    float2 qv[3]; float ss = 0.f;
#pragma unroll
    for (int i = 0; i < 3; ++i) { qv[i] = *(const float2*)(z + lane * 2 + 128 * i); ss += qv[i].x * qv[i].x + qv[i].y * qv[i].y; }
    const float4 kv = *(const float4*)(z + 384 + lane * 4);
    float sk = kv.x * kv.x + kv.y * kv.y + kv.z * kv.z + kv.w * kv.w;
    const float kr = z[640 + lane];
    ss = wave_sum(ss); sk = wave_sum(sk);
    const float rq = rsqrtf(ss * (1.f / 384.f) + 1e-6f);
    const float rk = rsqrtf(sk * (1.f / 256.f) + 1e-6f);
#pragma unroll
    for (int i = 0; i < 3; ++i) {
      const float2 w = *(const float2*)(qnw + lane * 2 + 128 * i);
      *(unsigned*)(qn + (size_t)r * 384 + lane * 2 + 128 * i) = pk2(qv[i].x * rq * w.x, qv[i].y * rq * w.y);
    }
    size_t kvrow; float *dck, *dkr; int pos;
    if (r < M_PROMPT) {
      kvrow = r; pos = r & 8191;
      dck = p.out + OUT_CKVP + ((size_t)o * 16384 + r) * 256;
      dkr = p.out + OUT_KRP + ((size_t)o * 16384 + r) * 64;
    } else {
      const int rr = r - M_PROMPT, b = rr >> 5, s = rr & 31;
      kvrow = (size_t)M_PROMPT + b * KSTR_S + 1024 + s; pos = 1024 + s;
      dck = p.out + OUT_CKVS + ((size_t)o * 512 + rr) * 256;
      dkr = p.out + OUT_KRS + ((size_t)o * 512 + rr) * 64;
    }
    const float4 w4 = *(const float4*)(kvw + lane * 4);
    const float c0 = kv.x * rk * w4.x, c1 = kv.y * rk * w4.y, c2 = kv.z * rk * w4.z, c3 = kv.w * rk * w4.w;
    *(float4*)(dck + lane * 4) = make_float4(c0, c1, c2, c3);
    st_bf4(ckvb + kvrow * 256 + lane * 4, c0, c1, c2, c3);
    const float other = __shfl_xor(kr, 32, 64);
    const float2 cs = rope[pos * 32 + (lane & 31)];
    const float ro = lane < 32 ? kr * cs.x - other * cs.y : kr * cs.x + other * cs.y;
    dkr[lane] = ro;
    krb[kvrow * 64 + lane] = f2bf(ro);
  }
  const int gt = blockIdx.x * 256 + tid, gs = gridDim.x * 256;
  const float* cck = p.cache_ckv + (size_t)o * 16 * 1024 * 256;
  const float* ckr = p.cache_krope + (size_t)o * 16 * 1024 * 64;
  for (int idx = gt; idx < 524288; idx += gs) {
    const int b = idx >> 15, rem = idx & 32767, k = rem >> 5, c8 = (rem & 31) * 8;
    const float* s = cck + ((size_t)(b * 1024 + k)) * 256 + c8;
    const float4 a0 = *(const float4*)s, a1 = *(const float4*)(s + 4);
    *(uint4*)(ckvb + ((size_t)M_PROMPT + b * KSTR_S + k) * 256 + c8) = make_uint4(pk2(a0.x, a0.y), pk2(a0.z, a0.w), pk2(a1.x, a1.y), pk2(a1.z, a1.w));
  }
  for (int idx = gt; idx < 131072; idx += gs) {
    const int b = idx >> 13, rem = idx & 8191, k = rem >> 3, c8 = (rem & 7) * 8;
    const float* s = ckr + ((size_t)(b * 1024 + k)) * 64 + c8;
    const float4 a0 = *(const float4*)s, a1 = *(const float4*)(s + 4);
    *(uint4*)(krb + ((size_t)M_PROMPT + b * KSTR_S + k) * 64 + c8) = make_uint4(pk2(a0.x, a0.y), pk2(a0.z, a0.w), pk2(a1.x, a1.y), pk2(a1.z, a1.w));
  }
  for (int idx = gt; idx < 16 * 96 * 32; idx += gs) {
    const int b = idx / 3072, rem = idx % 3072, k = 1056 + (rem >> 5), c8 = (rem & 31) * 8;
    *(uint4*)(ckvb + ((size_t)M_PROMPT + b * KSTR_S + k) * 256 + c8) = make_uint4(0, 0, 0, 0);
  }
  for (int idx = gt; idx < 16 * 96 * 8; idx += gs) {
    const int b = idx / 768, rem = idx % 768, k = 1056 + (rem >> 3), c8 = (rem & 7) * 8;
    *(uint4*)(krb + ((size_t)M_PROMPT + b * KSTR_S + k) * 64 + c8) = make_uint4(0, 0, 0, 0);
  }
}

DI void attn_item(const u16* __restrict__ qbuf, const u16* __restrict__ knope, const u16* __restrict__ krope,
                  const u16* __restrict__ vt, long vt_ld, u16* __restrict__ ao, int head, int qrow0, int nwaves,
                  long kvrow0, int ntiles, int tiles_lo, int nkeys, char* smem) {
  int tid = threadIdx.x;
  asm volatile("" : "+v"(tid));
  const int lane = tid & 63, wave = tid >> 6;
  const int l31 = lane & 31, h2 = lane >> 5;
  const bool active = wave < nwaves;
  const int my_tiles = wave < 2 ? tiles_lo : ntiles;
  const int qrow = qrow0 + wave * 32 + l31;
  const int rsw = (l31 >> 1) & 7;
  int koff[4];
#pragma unroll
  for (int c4 = 0; c4 < 4; ++c4) koff[c4] = l31 * 128 + (((2 * c4 + h2) ^ rsw) << 4);
  bf16x8 qf[4];
  if (active) {
    const u16* qp = qbuf + (size_t)qrow * 1536 + head * 192 + h2 * 8;
#pragma unroll
    for (int ks = 0; ks < 4; ++ks) qf[ks] = *(const bf16x8*)(qp + ks * 16);
#pragma unroll
    for (int ks = 4; ks < 12; ++ks)
      *(bf16x8*)(smem + 40960 + wave * 8192 + (ks >> 3) * 4096 + koff[ks & 3]) = *(const bf16x8*)(qp + ks * 16);
  } else {
#pragma unroll
    for (int ks = 0; ks < 4; ++ks) qf[ks] = (bf16x8){0, 0, 0, 0, 0, 0, 0, 0};
  }
  f32x16 oacc[4];
#pragma unroll
  for (int i = 0; i < 4; ++i)
#pragma unroll
    for (int j = 0; j < 16; ++j) oacc[i][j] = 0.f;
  float m_run = -INFINITY, l_run = 0.f;

  const int kr_r = tid >> 4, kr_c = tid & 15;
  const int rr_r = tid >> 3, rr_c = tid & 7;
  unsigned ko = (unsigned)((kvrow0 + kr_r) * 1024 + head * 128 + kr_c * 8);
  unsigned ro = (unsigned)((kvrow0 + rr_r) * 64 + rr_c * 8);
  unsigned vo = (unsigned)((head * 128 + rr_r) * vt_ld + rr_c * 8);
  const unsigned vld32 = (unsigned)vt_ld * 32u;
  const int k_lds = (kr_c >> 3) * 8192 + kr_r * 128 + (((kr_c & 7) ^ ((kr_r >> 1) & 7)) << 4);
  const int r_lds = 16384 + rr_r * 128 + ((rr_c ^ ((rr_r >> 1) & 7)) << 4);
  const int vsw = (rr_r >> 1) & 7;
  const int v_lds_lo = 24576 + rr_r * 128 + (((2 * (rr_c >> 1)) ^ vsw) << 4) + (rr_c & 1) * 8;
  const int v_lds_hi = 24576 + rr_r * 128 + (((2 * (rr_c >> 1) + 1) ^ vsw) << 4) + (rr_c & 1) * 8;
  u32x4 kreg[4], rreg[2], vreg[4];
#pragma unroll
  for (int i = 0; i < 4; ++i) kreg[i] = *(const u32x4*)(knope + (ko + (unsigned)(16 * i) * 1024u));
#pragma unroll
  for (int i = 0; i < 2; ++i) rreg[i] = *(const u32x4*)(krope + (ro + (unsigned)(32 * i) * 64u));
#pragma unroll
  for (int i = 0; i < 4; ++i) vreg[i] = *(const u32x4*)(vt + (vo + (unsigned)i * vld32));
  for (int kt = 0; kt < ntiles; ++kt) {
    __syncthreads();
#pragma unroll
    for (int i = 0; i < 4; ++i) *(u32x4*)(smem + k_lds + i * 2048) = kreg[i];
#pragma unroll
    for (int i = 0; i < 2; ++i) *(u32x4*)(smem + r_lds + i * 4096) = rreg[i];
#pragma unroll
    for (int i = 0; i < 4; ++i) {
      *(u32x2*)(smem + v_lds_lo + i * 4096) = (u32x2){vreg[i][0], vreg[i][1]};
      *(u32x2*)(smem + v_lds_hi + i * 4096) = (u32x2){vreg[i][2], vreg[i][3]};
    }
    __syncthreads();
    if (kt + 1 < ntiles) {
      ko += 64u * 1024u; ro += 64u * 64u; vo += 64u;
#pragma unroll
      for (int i = 0; i < 4; ++i) kreg[i] = *(const u32x4*)(knope + (ko + (unsigned)(16 * i) * 1024u));
#pragma unroll
      for (int i = 0; i < 2; ++i) rreg[i] = *(const u32x4*)(krope + (ro + (unsigned)(32 * i) * 64u));
#pragma unroll
      for (int i = 0; i < 4; ++i) vreg[i] = *(const u32x4*)(vt + (vo + (unsigned)i * vld32));
    }
    if (active && kt < my_tiles) {
#pragma unroll
      for (int mt = 0; mt < 2; ++mt) {
        f32x16 st;
#pragma unroll
        for (int j = 0; j < 16; ++j) st[j] = 0.f;
#pragma unroll
        for (int ks = 0; ks < 12; ++ks) {
          const bf16x8 kf = *(const bf16x8*)(smem + koff[ks & 3] + (ks >> 2) * 8192 + mt * 4096);
          bf16x8 qv;
          if (ks < 4) qv = qf[ks]; else qv = *(const bf16x8*)(smem + 40960 + wave * 8192 + (ks >> 3) * 4096 + koff[ks & 3]);
          st = __builtin_amdgcn_mfma_f32_32x32x16_bf16(kf, qv, st, 0, 0, 0);
        }
        if (kt * 64 + mt * 32 + 32 > nkeys) {
#pragma unroll
          for (int j = 0; j < 16; ++j) {
            const int key = kt * 64 + mt * 32 + (j & 3) + 8 * (j >> 2) + 4 * h2;
            if (key >= nkeys) st[j] = -INFINITY;
          }
        }
        float mx = st[0];
#pragma unroll
        for (int j = 1; j < 16; ++j) mx = fmaxf(mx, st[j]);
        mx = fmaxf(mx, __shfl_xor(mx, 32, 64));
        const float m_new = fmaxf(m_run, mx);
        const float alpha = __builtin_amdgcn_exp2f(m_run - m_new);
        m_run = m_new;
        float ps = 0.f;
#pragma unroll
        for (int j = 0; j < 16; ++j) { const float pv = __builtin_amdgcn_exp2f(st[j] - m_new); st[j] = pv; ps += pv; }
        l_run = l_run * alpha + ps;
        if (__any(alpha != 1.f)) {
#pragma unroll
          for (int i = 0; i < 4; ++i)
#pragma unroll
            for (int j = 0; j < 16; ++j) oacc[i][j] *= alpha;
        }
#pragma unroll
        for (int s = 0; s < 2; ++s) {
          union { bf16x8 v; unsigned u[4]; } pf;
#pragma unroll
          for (int k = 0; k < 4; ++k) pf.u[k] = pk2(st[8 * s + 2 * k], st[8 * s + 2 * k + 1]);
#pragma unroll
          for (int vt4 = 0; vt4 < 4; ++vt4) {
            const bf16x8 vf = *(const bf16x8*)(smem + 24576 + koff[mt * 2 + s] + vt4 * 4096);
            oacc[vt4] = __builtin_amdgcn_mfma_f32_32x32x16_bf16(vf, pf.v, oacc[vt4], 0, 0, 0);
          }
        }
      }
    }
  }
  if (active) {
    const float lt = l_run + __shfl_xor(l_run, 32, 64);
    const float inv = 1.f / lt;
    u16* op = ao + (size_t)qrow * 1024 + head * 128 + 4 * h2;
#pragma unroll
    for (int vt4 = 0; vt4 < 4; ++vt4)
#pragma unroll
      for (int a = 0; a < 4; ++a) {
        u16* q = op + vt4 * 32 + 8 * a;
        const uint2 gt = *(const uint2*)q;
        st_bf4(q, oacc[vt4][4 * a] * inv * bflo(gt.x), oacc[vt4][4 * a + 1] * inv * bfhi(gt.x),
               oacc[vt4][4 * a + 2] * inv * bflo(gt.y), oacc[vt4][4 * a + 3] * inv * bfhi(gt.y));
      }
  }
}

DI void attn_phase(const Params& p, char* smem) {
  const u16* qbuf = (const u16*)(p.ws + OFF_ZQ);
  const u16* knope = (const u16*)(p.ws + OFF_KN);
  const u16* krb = (const u16*)(p.ws + OFFB_KROPEB);
  const u16* vtb = (const u16*)(p.ws + OFF_VTO);
  u16* ao = (u16*)(p.ws + OFF_GO);
  for (int it = blockIdx.x; it < 640; it += gridDim.x) {
    if (it < 512) {
      const int bh = (it & 7) * 2 + ((it >> 3) & 1), qp = it >> 4;
      const int b = bh >> 3, h = bh & 7;
      const u16* vt = vtb + (size_t)b * 1024 * 8192;
#pragma unroll 1
      for (int half = 0; half < 2; ++half) {
        const int qb = half == 0 ? 63 - qp : qp;
        attn_item(qbuf, knope, krb, vt, 8192, ao, h, b * 8192 + qb * 128, 4, (long)b * 8192, 2 * qb + 2, 2 * qb + 1,
                  (2 * qb + 2) * 64, smem);
      }
    } else {
      const int s = it - 512, b = s >> 3, h = s & 7;
      const u16* vt = vtb + (size_t)2 * 1024 * 8192 + (size_t)b * 1024 * KSTR_S;
      attn_item(qbuf, knope, krb, vt, KSTR_S, ao, h, M_PROMPT + b * 32, 1, (long)M_PROMPT + (long)b * KSTR_S, 17, 17, 1056, smem);
    }
  }
}

DI void phase_even(const Params& p, int e, int sub, char* smem) {
  const int layer = 2 * e;
  u16* W = (u16*)(p.ws + OFF_W);
  u16* hbuf = (u16*)(p.ws + OFF_H);
  u16* abuf = (u16*)(p.ws + OFF_A);
  u16* uvbuf = (u16*)(p.ws + OFF_UV);
  u16* gbuf = (u16*)(p.ws + OFF_GATE);
  u16* vT = (u16*)(p.ws + OFF_VTE);
  if (sub == 0) {
    EpiE1 epi{abuf, uvbuf, gbuf, p.out + OUT_SPP + (size_t)e * 2 * 15 * 1024, p.out + OUT_SPS + (size_t)e * 16 * 15 * 1024};
    for (int t = blockIdx.x; t < 132 * 40; t += gridDim.x) {
      const int tm = t / 40, tn = t % 40;
      gemm_tile(hbuf + (size_t)tm * 128 * 1024, 1024, W + WE_IN + (size_t)tn * 128 * 1024, 1024, 1024, smem, tm * 128, tn * 128, epi);
    }
  } else if (sub == 1) {
    sgu_ln_items(p, e, smem);
    pool_d_items(p, e);
  } else if (sub == 2) {
    for (int t = blockIdx.x; t < 1056 + 1152; t += gridDim.x) {
      if (t < 1056) {
        const int g = t / 264, r = t % 264, tm = r >> 1, tn = r & 1;
        EpiPool epi{p.pool_scale + e * 1024, gbuf, g};
        gemm_tile(hbuf + (size_t)tm * 128 * 1024 + g * 256, 1024, W + WE_POOL + (size_t)g * 65536 + (size_t)tn * 128 * 256, 256, 256, smem,
                  tm * 128, tn * 128, epi);
      } else {
        const int u = t - 1056, c = u >> 3, g = (u >> 1) & 3, tn = u & 1;
        EpiSgu epi{p.b_spatial + (e * 4 + g) * 128, uvbuf, gbuf, g, c < 128 ? c * 128 : M_PROMPT + (c - 128) * 32, c < 128 ? 128 : 32};
        gemm_tile(W + WE_WS + (size_t)g * 16384, 128, vT + ((size_t)c * 1024 + g * 256 + tn * 128) * 128, 128, 128, smem, 0, tn * 128, epi);
      }
    }
  } else if (sub == 3) {
    EpiF32 epi{(float*)(p.ws + OFF_UV), 1024};
    for (int t = blockIdx.x; t < 132 * 8; t += gridDim.x) {
      const int tm = t >> 3, tn = t & 7;
      gemm_tile(gbuf + (size_t)tm * 128 * 2048, 2048, W + WE_OUT + (size_t)tn * 128 * 2048, 2048, 2048, smem, tm * 128, tn * 128, epi);
    }
  } else {
    resid_norm(p, layer, (const float*)(p.ws + OFF_UV));
    convert_weights(p, layer + 1, smem);
  }
}

DI void phase_odd(const Params& p, int o, int sub, char* smem) {
  const int layer = 2 * o + 1;
  u16* W = (u16*)(p.ws + OFF_W);
  u16* hbuf = (u16*)(p.ws + OFF_H);
  u16* ckvb = (u16*)(p.ws + OFF_CKVB);
  if (sub == 0) {
    EpiO1 epi{(float*)(p.ws + OFF_ZQ), (u16*)(p.ws + OFF_GO)};
    for (int t = blockIdx.x; t < 132 * 14; t += gridDim.x) {
      const int tm = t / 14, tn = t % 14;
      gemm_tile(hbuf + (size_t)tm * 128 * 1024, 1024, W + WO_IN + (size_t)tn * 128 * 1024, 1024, 1024, smem, tm * 128, tn * 128, epi);
    }
  } else if (sub == 1) {
    odd_rows(p, o);
  } else if (sub == 2) {
    EpiQup eq{(const float2*)(p.ws + OFFB_ROPE), (u16*)(p.ws + OFF_ZQ)};
    EpiBF16 ek{(u16*)(p.ws + OFF_KN), 1024};
    const u16* qn = (const u16*)(p.ws + OFF_QN);
    for (int t = blockIdx.x; t < 1584 + 2176; t += gridDim.x) {
      if (t < 1584) {
        const int tm = t / 12, tn = t % 12;
        gemm_tile(qn + (size_t)tm * 128 * 384, 384, W + WO_Q + (size_t)tn * 128 * 384, 384, 384, smem, tm * 128, tn * 128, eq);
      } else {
        const int u = t - 1584, tm = u >> 3, tn = u & 7;
        gemm_tile(ckvb + (size_t)tm * 128 * 256, 256, W + WO_KV + (size_t)tn * 256 * 256, 256, 256, smem, tm * 128, tn * 128, ek);
      }
    }
  } else if (sub == 3) {
    u16* vtb = (u16*)(p.ws + OFF_VTO);
    for (int t = blockIdx.x; t < 1024 + 1152; t += gridDim.x) {
      int b, tm, tn; long kv0, ld; u16* C;
      if (t < 1024) { b = t >> 9; const int r = t & 511; tm = r >> 6; tn = r & 63; kv0 = (long)b * 8192; ld = 8192; C = vtb + (size_t)b * 1024 * 8192; }
      else { const int u = t - 1024; b = u / 72; const int r = u % 72; tm = r / 9; tn = r % 9; kv0 = (long)M_PROMPT + (long)b * KSTR_S; ld = KSTR_S;
             C = vtb + (size_t)2 * 1024 * 8192 + (size_t)b * 1024 * KSTR_S; }
      EpiBF16 ev{C, ld};
      gemm_tile(W + WO_KV + (size_t)(tm * 256 + 128) * 256, 256, ckvb + (size_t)(kv0 + tn * 128) * 256, 256, 256, smem, tm * 128, tn * 128, ev);
    }
  } else if (sub == 4) {
    attn_phase(p, smem);
  } else if (sub == 5) {
    EpiF32 epi{(float*)(p.ws + OFF_KN), 1024};
    const u16* ao = (const u16*)(p.ws + OFF_GO);
    for (int t = blockIdx.x; t < 132 * 8; t += gridDim.x) {
      const int tm = t >> 3, tn = t & 7;
      gemm_tile(ao + (size_t)tm * 128 * 1024, 1024, W + WO_O + (size_t)tn * 128 * 1024, 1024, 1024, smem, tm * 128, tn * 128, epi);
    }
  } else {
    resid_norm(p, layer, (const float*)(p.ws + OFF_KN));
    if (layer < 3) convert_weights(p, layer + 1, smem);
  }
}

DI void run_phase(const Params& p, int ph, char* smem) {
  if (ph == 0) { convert_weights(p, 0, smem); prenorm0(p); }
  else if (ph <= 5) phase_even(p, 0, ph - 1, smem);
  else if (ph <= 12) phase_odd(p, 0, ph - 6, smem);
  else if (ph <= 17) phase_even(p, 1, ph - 13, smem);
  else phase_odd(p, 1, ph - 18, smem);
}

__global__ void __launch_bounds__(256, 2) k_phase(Params p, int ph) {
  __shared__ __attribute__((aligned(16))) char smem[73728];
  run_phase(p, ph, smem);
}

#if USE_COOP
__global__ void __launch_bounds__(256, 2) k_mega(Params p) {
  __shared__ __attribute__((aligned(16))) char smem[73728];
  cg::grid_group grid = cg::this_grid();
  for (int ph = 0; ph < NPHASE; ++ph) {
    run_phase(p, ph, smem);
    if (ph + 1 < NPHASE) grid.sync();
  }
}
#endif

extern "C" void kernel_launch(void* const* d_in, const int* in_sizes, int n_in, void* d_out, int out_size, void* d_ws,
                              size_t ws_size, hipStream_t stream) {
  (void)in_sizes; (void)n_in; (void)out_size;
  if (ws_size < 268435456ull) { fprintf(stderr, "ws too small: %zu\n", ws_size); return; }
  Params p{};
  p.x_prompt = (const float*)d_in[0]; p.x_sample = (const float*)d_in[1]; p.cache_pool = (const float*)d_in[2];
  p.cache_ckv = (const float*)d_in[3]; p.cache_krope = (const float*)d_in[4]; p.norm_pre = (const float*)d_in[5];
  p.norm_post = (const float*)d_in[6]; p.w_in_even = (const float*)d_in[7]; p.w_pool = (const float*)d_in[8];
  p.pool_scale = (const float*)d_in[9]; p.sgu_ln_g = (const float*)d_in[10]; p.sgu_ln_b = (const float*)d_in[11];
  p.w_spatial = (const float*)d_in[12]; p.b_spatial = (const float*)d_in[13]; p.w_out_even = (const float*)d_in[14];
  p.w_in_odd = (const float*)d_in[15]; p.q_norm = (const float*)d_in[16]; p.kv_norm = (const float*)d_in[17];
  p.w_q_up = (const float*)d_in[18]; p.w_kv_up = (const float*)d_in[19]; p.w_o = (const float*)d_in[20];
  p.out = (float*)d_out; p.ws = (char*)d_ws;
#if USE_COOP
  static int grid_blocks = 0;
  if (!grid_blocks) {
    int dev = 0, cus = 0, per_cu = 0;
    hipGetDevice(&dev);
    hipDeviceGetAttribute(&cus, hipDeviceAttributeMultiprocessorCount, dev);
    hipOccupancyMaxActiveBlocksPerMultiprocessor(&per_cu, k_mega, 256, 0);
    if (per_cu > 2) per_cu = 2;
    if (per_cu < 1) per_cu = 1;
    grid_blocks = cus * per_cu;
  }
  void* args[] = {&p};
  hipError_t e = hipLaunchCooperativeKernel((void*)k_mega, dim3(grid_blocks), dim3(256), args, 0, stream);
  if (e != hipSuccess) fprintf(stderr, "cooperative launch failed: %s (grid %d)\n", hipGetErrorString(e), grid_blocks);
#else
  for (int ph = 0; ph < NPHASE; ++ph) hipLaunchKernelGGL(k_phase, dim3(512), dim3(256), 0, stream, p, ph);
#endif
}
```

```cpp
#include <hip/hip_runtime.h>
#include <hip/hip_cooperative_groups.h>
#include <cstdio>
namespace cg = cooperative_groups;

typedef unsigned short u16;
using bf16x8 = __attribute__((ext_vector_type(8))) short;
using f32x4 = __attribute__((ext_vector_type(4))) float;
using f32x16 = __attribute__((ext_vector_type(16))) float;
using u32x4 = __attribute__((ext_vector_type(4))) unsigned;
using u32x2 = __attribute__((ext_vector_type(2))) unsigned;
#define DI __device__ __forceinline__

#ifndef USE_COOP
#define USE_COOP 1
#endif
#ifndef PROBE_ATTN
#define PROBE_ATTN 0
#endif
#ifndef PROBE_GEMM
#define PROBE_GEMM 0
#endif

constexpr int M_TOK = 16896;
constexpr int M_PROMPT = 16384;
constexpr int KSTR_S = 1152;
constexpr int KVR = 16384 + 16 * KSTR_S;
constexpr int NPHASE = 25;
constexpr float QSCALE = 0.07216878364870322f * 1.4426950408889634f;

constexpr size_t OFF_W = 0;
constexpr size_t OFF_H = 16777216;
constexpr size_t SZ_H = 34603008;
constexpr size_t OFF_A = OFF_H + SZ_H;
constexpr size_t OFF_UV = OFF_A + SZ_H;
constexpr size_t OFF_GATE = OFF_UV + 69206016;
constexpr size_t OFF_VTE = OFF_GATE + 69206016;
constexpr size_t OFF_CKVB = OFF_H;
constexpr size_t OFF_QN = OFF_H + 17825792;
constexpr size_t OFF_VTO = OFF_QN;
constexpr size_t OFF_ZQ = OFF_VTO + 71303168;
constexpr size_t OFF_GO = OFF_ZQ + 51904512;
constexpr size_t OFF_KN = OFF_GO + 34603008;
constexpr size_t WS_NEED = OFF_KN + 71303168;
static_assert(WS_NEED <= 268435456, "ws");
static_assert(OFF_VTE + 37748736 <= 268435456, "ws");
constexpr size_t WE_IN = 0, WE_OUT = 5242880, WE_POOL = 7340032, WE_WS = 7602176;
constexpr size_t WO_IN = 0, WO_Q = 1835008, WO_KV = 2424832, WO_O = 2949120;
constexpr size_t OFFB_ROPE = 7995392, OFFB_KROPEB = 10092544;
constexpr size_t OUT_SPP = 17301504, OUT_SPS = 17362944, OUT_SGUV = 17854464, OUT_CKVP = 18903040,
                 OUT_KRP = 27291648, OUT_CKVS = 29388800, OUT_KRS = 29650944;

struct Params {
  const float *x_prompt, *x_sample, *cache_pool, *cache_ckv, *cache_krope, *norm_pre, *norm_post,
      *w_in_even, *w_pool, *pool_scale, *sgu_ln_g, *sgu_ln_b, *w_spatial, *b_spatial, *w_out_even,
      *w_in_odd, *q_norm, *kv_norm, *w_q_up, *w_kv_up, *w_o;
  float* out;
  char* ws;
};

DI int get_tid() { int t = threadIdx.x; asm volatile("" : "+v"(t)); return t; }
DI int get_bid() { int b = blockIdx.x; asm volatile("" : "+s"(b)); return b; }
DI float zero_f() { float z = 0.f; asm volatile("" : "+v"(z)); return z; }
DI u16 f2bf(float x) { unsigned u = __float_as_uint(x); u += 0x7fffu + ((u >> 16) & 1u); return (u16)(u >> 16); }
DI float bf2f(u16 v) { return __uint_as_float(((unsigned)v) << 16); }
typedef __bf16 bf16x2_t __attribute__((ext_vector_type(2)));
typedef float f32x2_t __attribute__((ext_vector_type(2)));
DI unsigned pk2(float a, float b) { f32x2_t f = {a, b}; return __builtin_bit_cast(unsigned, __builtin_convertvector(f, bf16x2_t)); }
DI float bflo(unsigned u) { return __uint_as_float(u << 16); }
DI float bfhi(unsigned u) { return __uint_as_float(u & 0xffff0000u); }
DI float wave_sum(float v) {
#pragma unroll
  for (int o = 32; o; o >>= 1) v += __shfl_xor(v, o, 64);
  return v;
}
DI float gelu_f(float x) { return 0.5f * x * (1.f + erff(x * 0.70710678118654752f)); }
DI float silu_f(float x) { return x * __builtin_amdgcn_rcpf(1.f + __expf(-x)); }
DI int tok_pos(int m) { return m < M_PROMPT ? (m & 8191) : 1024 + ((m - M_PROMPT) & 31); }

DI void dma16(const void* gsrc, unsigned lds_dst) {
  unsigned keep;
  asm volatile("s_mov_b32 %0, m0\n\ts_mov_b32 m0, %2\n\ts_nop 0\n\tglobal_load_lds_dwordx4 %1, off\n\ts_mov_b32 m0, %0"
               : "=&s"(keep) : "v"(gsrc), "s"(lds_dst) : "memory");
}
template <int MT, class Epi>
DI void gemm_tile(const u16* __restrict__ X, long ldx, const u16* __restrict__ W, long ldw, int K, char* smem,
                  int m0, int n0, const Epi& epi, bool pre = false, const u16* Xn = nullptr, const u16* Wn = nullptr) {
  const int tid = get_tid(), lane = tid & 63, wave = tid >> 6;
  const int wm = wave & 1, wn = wave >> 1;
  const int lr = lane & 15, g = lane >> 4;
  const int rsw = (lr >> 1) & 7;
  f32x4 acc[4][MT];
  { const float z = zero_f();
#pragma unroll
  for (int a = 0; a < 4; ++a)
#pragma unroll
    for (int b = 0; b < MT; ++b) acc[a][b] = (f32x4){z, z, z, z}; }
  const int wu = __builtin_amdgcn_readfirstlane(wave);
  const unsigned sbase = (unsigned)__builtin_amdgcn_readfirstlane((int)(unsigned)(size_t)smem);
  const int r8 = lane >> 3, c0 = (lane & 7) ^ (r8 >> 1);
  const long oxe = (long)(wu * MT * 8 + r8) * ldx + (c0 << 3), oxo = (long)(wu * MT * 8 + r8) * ldx + ((c0 ^ 4) << 3);
  const long owe = (long)(wu * 32 + r8) * ldw + (c0 << 3), owo = (long)(wu * 32 + r8) * ldw + ((c0 ^ 4) << 3);
  const u16 *xe = X + oxe, *xo = X + oxo, *we = W + owe, *wo = W + owo;
  const long ldx8 = 8 * ldx, ldw8 = 8 * ldw;
  const unsigned xdst = sbase + wu * MT * 1024, wdst = sbase + 16384 + wu * 4096;
#define GT_DMA(BUFOFF)                                                                                          \
  {                                                                                                            \
    _Pragma("unroll") for (int i = 0; i < MT; ++i) dma16(((i & 1) ? xo : xe) + i * ldx8, xdst + (BUFOFF) + i * 1024); \
    _Pragma("unroll") for (int i = 0; i < 4; ++i) dma16(((i & 1) ? wo : we) + i * ldw8, wdst + (BUFOFF) + i * 1024);  \
    xe += 64; xo += 64; we += 64; wo += 64;                                                                    \
  }
  if (!pre) {
    __syncthreads();
    GT_DMA(0u)
  } else {
    xe += 64; xo += 64; we += 64; wo += 64;
  }
  const int nk = K >> 6;
  int kt = 0;
  do {
    asm volatile("s_waitcnt vmcnt(0)" ::: "memory");
    __syncthreads();
    if (kt + 1 < nk) GT_DMA((unsigned)((kt + 1) & 1) * 32768u)
    else if (Xn != nullptr) { xe = Xn + oxe; xo = Xn + oxo; we = Wn + owe; wo = Wn + owo; GT_DMA(0u) }
    const char* cur = smem + (kt & 1) * 32768;
#pragma unroll
    for (int ks = 0; ks < 2; ++ks) {
      bf16x8 xf[MT], wf[4];
      const int ch = ((ks * 4 + g) ^ rsw) << 4;
#pragma unroll
      for (int i = 0; i < MT; ++i) xf[i] = *(const bf16x8*)(cur + (wm * 16 * MT + i * 16 + lr) * 128 + ch);
#pragma unroll
      for (int i = 0; i < 4; ++i) wf[i] = *(const bf16x8*)(cur + 16384 + (wn * 64 + i * 16 + lr) * 128 + ch);
      __builtin_amdgcn_s_setprio(1);
#pragma unroll
      for (int nt = 0; nt < 4; ++nt)
#pragma unroll
        for (int mt = 0; mt < MT; ++mt)
          acc[nt][mt] = __builtin_amdgcn_mfma_f32_16x16x32_bf16(wf[nt], xf[mt], acc[nt][mt], 0, 0, 0);
      __builtin_amdgcn_s_setprio(0);
    }
  } while (++kt < nk);
#undef GT_DMA
  epi.run(acc, m0 + wm * 16 * MT + lr, n0 + wn * 64 + 4 * g);
}

template <int N> DI void wait_vm() { asm volatile("s_waitcnt vmcnt(%0)" ::"n"(N) : "memory"); }

template <int BM, class Epi>
DI void gemm_dma(const u16* __restrict__ X, long ldx, const u16* __restrict__ W, long ldw, int K, char* smem,
                 int m0, int n0, const Epi& epi) {
  constexpr bool BIG = (BM == 256);
  constexpr int D = BIG ? 3 : 4;
  constexpr int STG = BM * 64 + 8192;
  constexpr int MT = BIG ? 4 : BM / 32;
  constexpr int NT = BIG ? 8 : 4;
  constexpr int XD = BM / 64;
  constexpr int PW = XD + 2;
  const int tid = get_tid(), lane = tid & 63, wave = tid >> 6;
  const int lr = lane & 15, g = lane >> 4;
  const int rd = lr * 64 + ((g ^ ((4 - (lr >> 2)) & 3)) << 4);
  const int xrow0 = BIG ? wave * 64 : (wave & 1) * (BM / 2);
  const int wrow0 = BIG ? 0 : (wave >> 1) * 64;
  f32x4 acc[NT][MT];
  { const float z = zero_f();
#pragma unroll
  for (int a = 0; a < NT; ++a)
#pragma unroll
    for (int b = 0; b < MT; ++b) acc[a][b] = (f32x4){z, z, z, z}; }
  const int wu = __builtin_amdgcn_readfirstlane(wave);
  const unsigned sbase = (unsigned)__builtin_amdgcn_readfirstlane((int)(unsigned)(size_t)smem);
  const int r16 = lane >> 2, chunk = (lane & 3) ^ ((4 - (r16 >> 2)) & 3);
  const u16* xs = X + (long)(wu * XD * 16 + r16) * ldx + (chunk << 3);
  const u16* ws = W + (long)(wu * 32 + r16) * ldw + (chunk << 3);
  const long ldx16 = 16 * ldx, ldw16 = 16 * ldw;
  const unsigned xdst = sbase + wu * XD * 1024, wdst = sbase + BM * 64 + wu * 2048;
#define GD_ISSUE(BUF)                                                                                           \
  {                                                                                                            \
    _Pragma("unroll") for (int i = 0; i < XD; ++i) dma16(xs + i * ldx16, xdst + (unsigned)(BUF) * STG + i * 1024); \
    _Pragma("unroll") for (int i = 0; i < 2; ++i) dma16(ws + i * ldw16, wdst + (unsigned)(BUF) * STG + i * 1024);  \
    xs += 32; ws += 32;                                                                                        \
  }
  const int nk = K >> 5;
  __syncthreads();
#pragma unroll
  for (int s = 0; s < D - 1; ++s) GD_ISSUE(s)
  int cur = 0, nxt = D - 1, kt = 0;
  do {
    if (kt + D - 2 < nk) wait_vm<PW * (D - 2)>(); else wait_vm<0>();
    __syncthreads();
    if (kt + D - 1 < nk) GD_ISSUE(nxt)
    nxt = (nxt + 1 == D) ? 0 : nxt + 1;
    const char* base = smem + cur * STG;
    cur = (cur + 1 == D) ? 0 : cur + 1;
    bf16x8 xf[MT];
#pragma unroll
    for (int i = 0; i < MT; ++i) xf[i] = *(const bf16x8*)(base + (xrow0 + i * 16) * 64 + rd);
#pragma unroll
    for (int nh = 0; nh < NT / 4; ++nh) {
      bf16x8 wf[4];
#pragma unroll
      for (int i = 0; i < 4; ++i) wf[i] = *(const bf16x8*)(base + BM * 64 + (wrow0 + (nh * 4 + i) * 16) * 64 + rd);
      __builtin_amdgcn_s_setprio(1);
#pragma unroll
      for (int i = 0; i < 4; ++i)
#pragma unroll
        for (int mt = 0; mt < MT; ++mt)
          acc[nh * 4 + i][mt] = __builtin_amdgcn_mfma_f32_16x16x32_bf16(wf[i], xf[mt], acc[nh * 4 + i][mt], 0, 0, 0);
      __builtin_amdgcn_s_setprio(0);
    }
  } while (++kt < nk);
#undef GD_ISSUE
  epi.run(acc, m0 + xrow0 + lr, n0 + wrow0 + 4 * g);
}

template <class Epi>
DI void gemm_big(const u16* __restrict__ X, long ldx, const u16* __restrict__ W, long ldw, int K, char* smem,
                 int m0, int n0, const Epi& epi) {
  const int tid = get_tid(), lane = tid & 63, wave = tid >> 6;
  const int lr = lane & 15, g = lane >> 4;
  const int rsw = (lr >> 1) & 7;
  const int rd0 = lr * 128 + (((2 * g) ^ rsw) << 4), rd1 = lr * 128 + (((2 * g + 1) ^ rsw) << 4);
  f32x4 acc[8][4];
  { const float z = zero_f();
#pragma unroll
  for (int a = 0; a < 8; ++a)
#pragma unroll
    for (int b = 0; b < 4; ++b) acc[a][b] = (f32x4){z, z, z, z}; }
  const u16* xp = X + (long)(wave * 64 + lr) * ldx + 16 * g;
  const long ldx16 = 16 * ldx;
  const int wrow = wave * 8 + (lane >> 3);
  const u16* wp = W + (long)wrow * ldw + (((lane & 7) ^ ((wrow >> 1) & 7)) << 3);
  const long ldw32 = 32 * ldw;
  const int wdst = tid * 16;
  bf16x8 xa[4], xb[4];
  __syncthreads();
#pragma unroll
  for (int i = 0; i < 4; ++i)
    __builtin_amdgcn_global_load_lds((const unsigned*)(wp + i * ldw32), (unsigned*)(smem + wdst + i * 4096), 16, 0, 0);
#pragma unroll
  for (int mt = 0; mt < 4; ++mt) { xa[mt] = *(const bf16x8*)(xp + mt * ldx16); xb[mt] = *(const bf16x8*)(xp + mt * ldx16 + 8); }
  __syncthreads();
  const int nk = K >> 6;
  int kt = 0;
  do {
    const char* cur = smem + (kt & 1) * 16384;
    char* nxt = smem + ((kt & 1) ^ 1) * 16384;
    const int adv = (kt + 1 < nk) ? 64 : 0;
    xp += adv; wp += adv;
#pragma unroll
    for (int i = 0; i < 4; ++i)
      __builtin_amdgcn_global_load_lds((const unsigned*)(wp + i * ldw32), (unsigned*)(nxt + wdst + i * 4096), 16, 0, 0);
#pragma unroll
    for (int nh = 0; nh < 2; ++nh) {
      bf16x8 wf[4];
#pragma unroll
      for (int i = 0; i < 4; ++i) wf[i] = *(const bf16x8*)(cur + rd0 + (nh * 4 + i) * 2048);
#pragma unroll
      for (int i = 0; i < 4; ++i)
#pragma unroll
        for (int mt = 0; mt < 4; ++mt)
          acc[nh * 4 + i][mt] = __builtin_amdgcn_mfma_f32_16x16x32_bf16(wf[i], xa[mt], acc[nh * 4 + i][mt], 0, 0, 0);
    }
#pragma unroll
    for (int mt = 0; mt < 4; ++mt) xa[mt] = *(const bf16x8*)(xp + mt * ldx16);
#pragma unroll
    for (int nh = 0; nh < 2; ++nh) {
      bf16x8 wf[4];
#pragma unroll
      for (int i = 0; i < 4; ++i) wf[i] = *(const bf16x8*)(cur + rd1 + (nh * 4 + i) * 2048);
#pragma unroll
      for (int i = 0; i < 4; ++i)
#pragma unroll
        for (int mt = 0; mt < 4; ++mt)
          acc[nh * 4 + i][mt] = __builtin_amdgcn_mfma_f32_16x16x32_bf16(wf[i], xb[mt], acc[nh * 4 + i][mt], 0, 0, 0);
    }
#pragma unroll
    for (int mt = 0; mt < 4; ++mt) xb[mt] = *(const bf16x8*)(xp + mt * ldx16 + 8);
    __syncthreads();
  } while (++kt < nk);
  epi.run(acc, m0 + wave * 64 + lr, n0 + 4 * g);
}

DI void st_bf4(u16* p, float a, float b, float c, float d) { *(uint2*)p = make_uint2(pk2(a, b), pk2(c, d)); }

struct EpiE1 {
  u16 *abuf, *uvbuf, *gatebuf; float *spp, *sps;
  template <int NT, int MT> DI void run(f32x4 (&acc)[NT][MT], int mb, int nb) const {
#pragma unroll
    for (int nt = 0; nt < NT; ++nt) {
      const int n = nb + nt * 16;
#pragma unroll
      for (int mt = 0; mt < MT; ++mt) {
        const int m = mb + mt * 16;
        f32x4 v = acc[nt][mt];
        if (n < 1024) {
          st_bf4(abuf + (size_t)m * 1024 + n, v[0], v[1], v[2], v[3]);
          float* dst = nullptr;
          if (m < M_PROMPT) { int t = m & 8191; if (t >= 8177) dst = spp + ((size_t)((m >> 13) * 15 + (t - 8177))) * 1024 + n; }
          else { int r = m - M_PROMPT; int s = r & 31; if (s >= 17) dst = sps + ((size_t)((r >> 5) * 15 + (s - 17))) * 1024 + n; }
          if (dst) *(float4*)dst = make_float4(v[0], v[1], v[2], v[3]);
        } else if (n < 3072) {
          st_bf4(uvbuf + (size_t)m * 2048 + (n - 1024), gelu_f(v[0]), gelu_f(v[1]), gelu_f(v[2]), gelu_f(v[3]));
        } else {
          st_bf4(gatebuf + (size_t)m * 2048 + (n - 3072), silu_f(v[0]), silu_f(v[1]), silu_f(v[2]), silu_f(v[3]));
        }
        __builtin_amdgcn_sched_barrier(0);
      }
    }
  }
};

struct EpiPool {
  const float* scale; u16* mix; int g;
  template <int NT, int MT> DI void run(f32x4 (&acc)[NT][MT], int mb, int nb) const {
#pragma unroll
    for (int nt = 0; nt < NT; ++nt) {
      const int ch = g * 256 + nb + nt * 16;
      const float4 sc = *(const float4*)(scale + ch);
#pragma unroll
      for (int mt = 0; mt < MT; ++mt) {
        const int m = mb + mt * 16;
        u16* q = mix + (size_t)m * 2048 + ch;
        const uint2 gt = *(const uint2*)q;
        f32x4 v = acc[nt][mt];
        st_bf4(q, v[0] * sc.x * bflo(gt.x), v[1] * sc.y * bfhi(gt.x), v[2] * sc.z * bflo(gt.y), v[3] * sc.w * bfhi(gt.y));
      }
    }
  }
};

struct EpiSgu {
  const float* bs; const u16* uv; u16* mix; int g, rowbase, nvalid;
  template <int NT, int MT> DI void run(f32x4 (&acc)[NT][MT], int mb, int nb) const {
#pragma unroll
    for (int mt = 0; mt < MT; ++mt) {
      const int i = mb + mt * 16;
      if (i < nvalid) {
        const float bias = bs[i];
        const size_t row = (size_t)(rowbase + i);
#pragma unroll
        for (int nt = 0; nt < NT; ++nt) {
          const int ch = g * 256 + nb + nt * 16;
          const uint2 uu = *(const uint2*)(uv + row * 2048 + ch);
          u16* q = mix + row * 2048 + 1024 + ch;
          const uint2 gt = *(const uint2*)q;
          f32x4 v = acc[nt][mt];
          st_bf4(q, (v[0] + bias) * bflo(uu.x) * bflo(gt.x), (v[1] + bias) * bfhi(uu.x) * bfhi(gt.x),
                 (v[2] + bias) * bflo(uu.y) * bflo(gt.y), (v[3] + bias) * bfhi(uu.y) * bfhi(gt.y));
        }
      }
    }
  }
};

struct EpiF32 {
  float* C; long ldc;
  template <int NT, int MT> DI void run(f32x4 (&acc)[NT][MT], int mb, int nb) const {
#pragma unroll
    for (int nt = 0; nt < NT; ++nt)
#pragma unroll
      for (int mt = 0; mt < MT; ++mt) {
        f32x4 v = acc[nt][mt];
        *(float4*)(C + (size_t)(mb + mt * 16) * ldc + nb + nt * 16) = make_float4(v[0], v[1], v[2], v[3]);
      }
  }
};

struct EpiBF16 {
  u16* C; long ldc;
  template <int NT, int MT> DI void run(f32x4 (&acc)[NT][MT], int mb, int nb) const {
#pragma unroll
    for (int nt = 0; nt < NT; ++nt)
#pragma unroll
      for (int mt = 0; mt < MT; ++mt) {
        f32x4 v = acc[nt][mt];
        st_bf4(C + (size_t)(mb + mt * 16) * ldc + nb + nt * 16, v[0], v[1], v[2], v[3]);
      }
  }
};

struct EpiVT {
  u16* C; long ldc;
  template <int NT, int MT> DI void run(f32x4 (&acc)[NT][MT], int mb, int nb) const {
#pragma unroll
    for (int nt = 0; nt < NT; ++nt) {
      const int n = nb + nt * 16;
      const int np = (n & ~12) | ((n & 4) << 1) | ((n & 8) >> 1);
#pragma unroll
      for (int mt = 0; mt < MT; ++mt) {
        f32x4 v = acc[nt][mt];
        st_bf4(C + (size_t)(mb + mt * 16) * ldc + np, v[0], v[1], v[2], v[3]);
      }
    }
  }
};

struct EpiO1 {
  float* zq; u16* gate;
  template <int NT, int MT> DI void run(f32x4 (&acc)[NT][MT], int mb, int nb) const {
#pragma unroll
    for (int nt = 0; nt < NT; ++nt) {
      const int n = nb + nt * 16;
#pragma unroll
      for (int mt = 0; mt < MT; ++mt) {
        const int m = mb + mt * 16;
        f32x4 v = acc[nt][mt];
        if (n < 704) *(float4*)(zq + (size_t)m * 704 + n) = make_float4(v[0], v[1], v[2], v[3]);
        else if (n < 1728) st_bf4(gate + (size_t)m * 1024 + (n - 704), silu_f(v[0]), silu_f(v[1]), silu_f(v[2]), silu_f(v[3]));
        __builtin_amdgcn_sched_barrier(0);
      }
    }
  }
};

struct EpiQup {
  const float2* rope; u16* q;
  template <int NT, int MT> DI void run(f32x4 (&acc)[NT][MT], int mb, int nb) const {
    const int g4 = nb & 15;
#pragma unroll
    for (int q4 = 0; q4 < NT / 4; ++q4) {
      const int grp = ((nb - g4) >> 6) + q4;
      if ((grp % 3) == 2) {
#pragma unroll
        for (int mt = 0; mt < MT; ++mt) {
          const int pos = tok_pos(mb + mt * 16);
#pragma unroll
          for (int nt = 0; nt < 2; ++nt)
#pragma unroll
            for (int j = 0; j < 4; ++j) {
              const float2 cs = rope[pos * 32 + nt * 16 + g4 + j];
              const float x1 = acc[q4 * 4 + nt][mt][j], x2 = acc[q4 * 4 + nt + 2][mt][j];
              acc[q4 * 4 + nt][mt][j] = x1 * cs.x - x2 * cs.y;
              acc[q4 * 4 + nt + 2][mt][j] = x2 * cs.x + x1 * cs.y;
            }
        }
      }
    }
#pragma unroll
    for (int nt = 0; nt < NT; ++nt)
#pragma unroll
      for (int mt = 0; mt < MT; ++mt) {
        f32x4 v = acc[nt][mt];
        st_bf4(q + (size_t)(mb + mt * 16) * 1536 + nb + nt * 16, v[0] * QSCALE, v[1] * QSCALE, v[2] * QSCALE, v[3] * QSCALE);
      }
  }
};

DI void tconv_tile(const float* __restrict__ src, long lds, int cvalid, u16* __restrict__ dst, long ldd, int r0, int c0, char* smem) {
  float (*T)[65] = (float (*)[65])smem;
  const int tid = get_tid();
  __syncthreads();
  const int lr = tid >> 4, lc = (tid & 15) * 4;
#pragma unroll
  for (int i = 0; i < 4; ++i) {
    const int r = lr + 16 * i;
    float4 v = make_float4(0.f, 0.f, 0.f, 0.f);
    if (c0 + lc < cvalid) v = *(const float4*)(src + (long)(r0 + r) * lds + c0 + lc);
    T[r][lc] = v.x; T[r][lc + 1] = v.y; T[r][lc + 2] = v.z; T[r][lc + 3] = v.w;
  }
  __syncthreads();
  const int oc = tid >> 2, seg = (tid & 3) * 16;
  unsigned pk[8];
#pragma unroll
  for (int k = 0; k < 8; ++k) pk[k] = pk2(T[seg + 2 * k][oc], T[seg + 2 * k + 1][oc]);
  uint4* d = (uint4*)(dst + (long)(c0 + oc) * ldd + r0 + seg);
  d[0] = make_uint4(pk[0], pk[1], pk[2], pk[3]);
  d[1] = make_uint4(pk[4], pk[5], pk[6], pk[7]);
}

DI void convert_weights(const Params& p, int layer, char* smem) {
  u16* W = (u16*)(p.ws + OFF_W);
  const int tid = get_tid();
  if ((layer & 1) == 0) {
    const int e = layer >> 1;
    for (int t = get_bid(); t < 1920; t += gridDim.x) {
      if (t < 1280) {
        tconv_tile(p.w_in_even + (size_t)e * 1024 * 5120, 5120, 5120, W + WE_IN, 1024, (t / 80) * 64, (t % 80) * 64, smem);
      } else if (t < 1792) {
        const int u = t - 1280;
        tconv_tile(p.w_out_even + (size_t)e * 2048 * 1024, 1024, 1024, W + WE_OUT, 2048, (u >> 4) * 64, (u & 15) * 64, smem);
      } else if (t < 1856) {
        const int u = t - 1792, g = u >> 4, v = u & 15;
        tconv_tile(p.w_pool + (size_t)(e * 4 + g) * 65536, 256, 256, W + WE_POOL + (size_t)g * 65536, 256, (v >> 2) * 64, (v & 3) * 64, smem);
      } else {
        const int idx = (t - 1856) * 1024 + tid * 4;
        const int i = (idx >> 7) & 127, j = idx & 127;
        float4 v = *(const float4*)(p.w_spatial + (size_t)e * 65536 + idx);
        if ((j >> 6) > (i >> 6)) v = make_float4(0.f, 0.f, 0.f, 0.f);
        st_bf4(W + WE_WS + idx, v.x, v.y, v.z, v.w);
      }
    }
  } else {
    const int o = layer >> 1;
    float2* rope = (float2*)(p.ws + OFFB_ROPE);
    for (int t = get_bid(); t < 2000; t += gridDim.x) {
      if (t < 448) {
        tconv_tile(p.w_in_odd + (size_t)o * 1024 * 1728, 1728, 1728, W + WO_IN, 1024, (t / 28) * 64, (t % 28) * 64, smem);
      } else if (t < 592) {
        const int u = t - 448;
        tconv_tile(p.w_q_up + (size_t)o * 384 * 1536, 1536, 1536, W + WO_Q, 384, (u / 24) * 64, (u % 24) * 64, smem);
      } else if (t < 720) {
        const int u = t - 592;
        const int c0 = (u & 31) * 64, hh = c0 >> 8, j0 = c0 & 255;
        const int drow0 = j0 < 128 ? hh * 128 + j0 : 1024 + hh * 128 + (j0 - 128);
        tconv_tile(p.w_kv_up + (size_t)o * 256 * 2048, 2048, 2048, W + WO_KV + (long)(drow0 - c0) * 256, 256, (u >> 5) * 64, c0, smem);
      } else if (t < 976) {
        const int u = t - 720;
        tconv_tile(p.w_o + (size_t)o * 1024 * 1024, 1024, 1024, W + WO_O, 1024, (u >> 4) * 64, (u & 15) * 64, smem);
      } else {
        const int idx = (t - 976) * 256 + tid;
        const int pos = idx >> 5, i = idx & 31;
        const float freq = exp2f(-(float)i * (13.287712379549449f / 32.f));
        const float ang = (float)pos * freq;
        float s, c;
        sincosf(ang, &s, &c);
        rope[idx] = make_float2(c, s);
      }
    }
  }
}

DI void prenorm0(const Params& p) {
  const int lane = get_tid() & 63;
  u16* h = (u16*)(p.ws + OFF_H);
  for (int r = get_bid() * 4 + (get_tid() >> 6); r < M_TOK; r += gridDim.x * 4) {
    const float* x = r < M_PROMPT ? p.x_prompt + (size_t)r * 1024 : p.x_sample + (size_t)(r - M_PROMPT) * 1024;
    float4 v[4]; float ss = 0.f;
#pragma unroll
    for (int i = 0; i < 4; ++i) { v[i] = *(const float4*)(x + lane * 4 + 256 * i); ss += v[i].x * v[i].x + v[i].y * v[i].y + v[i].z * v[i].z + v[i].w * v[i].w; }
    ss = wave_sum(ss);
    const float rs = rsqrtf(ss * (1.f / 1024.f) + 1e-6f);
#pragma unroll
    for (int i = 0; i < 4; ++i) {
      const float4 gg = *(const float4*)(p.norm_pre + lane * 4 + 256 * i);
      st_bf4(h + (size_t)r * 1024 + lane * 4 + 256 * i, v[i].x * rs * gg.x, v[i].y * rs * gg.y, v[i].z * rs * gg.z, v[i].w * rs * gg.w);
    }
  }
}

DI void resid_norm(const Params& p, int layer, const u16* __restrict__ y) {
  const int lane = get_tid() & 63;
  u16* h = (u16*)(p.ws + OFF_H);
  const float* gpost = p.norm_post + layer * 1024;
  const float* gpre = p.norm_pre + (layer + 1) * 1024;
  for (int r = get_bid() * 4 + (get_tid() >> 6); r < M_TOK; r += gridDim.x * 4) {
    const float* x;
    if (layer == 0) x = r < M_PROMPT ? p.x_prompt + (size_t)r * 1024 : p.x_sample + (size_t)(r - M_PROMPT) * 1024;
    else x = p.out + (size_t)r * 1024;
    float4 yv[4], xv[4]; float ss = 0.f;
#pragma unroll
    for (int i = 0; i < 4; ++i) {
      { const uint2 yq = *(const uint2*)(y + (size_t)r * 1024 + lane * 4 + 256 * i); yv[i] = make_float4(bflo(yq.x), bfhi(yq.x), bflo(yq.y), bfhi(yq.y)); }
      xv[i] = *(const float4*)(x + lane * 4 + 256 * i);
      ss += yv[i].x * yv[i].x + yv[i].y * yv[i].y + yv[i].z * yv[i].z + yv[i].w * yv[i].w;
    }
    ss = wave_sum(ss);
    const float rs = rsqrtf(ss * (1.f / 1024.f) + 1e-6f);
    float ss2 = 0.f;
#pragma unroll
    for (int i = 0; i < 4; ++i) {
      const float4 gg = *(const float4*)(gpost + lane * 4 + 256 * i);
      xv[i].x += yv[i].x * rs * gg.x; xv[i].y += yv[i].y * rs * gg.y; xv[i].z += yv[i].z * rs * gg.z; xv[i].w += yv[i].w * rs * gg.w;
      *(float4*)(p.out + (size_t)r * 1024 + lane * 4 + 256 * i) = xv[i];
      ss2 += xv[i].x * xv[i].x + xv[i].y * xv[i].y + xv[i].z * xv[i].z + xv[i].w * xv[i].w;
    }
    if (layer < 3) {
      ss2 = wave_sum(ss2);
      const float rs2 = rsqrtf(ss2 * (1.f / 1024.f) + 1e-6f);
#pragma unroll
      for (int i = 0; i < 4; ++i) {
        const float4 gg = *(const float4*)(gpre + lane * 4 + 256 * i);
        st_bf4(h + (size_t)r * 1024 + lane * 4 + 256 * i, xv[i].x * rs2 * gg.x, xv[i].y * rs2 * gg.y, xv[i].z * rs2 * gg.z, xv[i].w * rs2 * gg.w);
      }
    }
  }
}

DI void sgu_ln_items(const Params& p, int e, char* smem) {
  const int tid = get_tid(), lane = tid & 63, wave = tid >> 6;
  const u16* uv = (const u16*)(p.ws + OFF_UV);
  u16* vT = (u16*)(p.ws + OFF_VTE);
  float2* st = (float2*)smem;
  u16* T = (u16*)(smem + 1024);
  const float* lg = p.sgu_ln_g + e * 1024;
  const float* lb = p.sgu_ln_b + e * 1024;
  for (int it = get_bid(); it < 576; it += gridDim.x) {
    const int c = it >> 2, gq = it & 3;
    const int rowbase = c < 128 ? c * 128 : M_PROMPT + (c - 128) * 32;
    const int nvalid = c < 128 ? 128 : 32;
    __syncthreads();
#pragma unroll 1
    for (int b8 = 0; b8 < 32; b8 += 8) {
      u32x4 q[8][2];
#pragma unroll
      for (int k = 0; k < 8; ++k) {
        const int i = wave * 32 + b8 + k;
        const int ic = i < nvalid ? i : 0;
        const u16* src = uv + (size_t)(rowbase + ic) * 2048 + 1024 + lane * 8;
        q[k][0] = *(const u32x4*)src;
        q[k][1] = *(const u32x4*)(src + 512);
      }
#pragma unroll
      for (int k = 0; k < 8; ++k) {
        const int i = wave * 32 + b8 + k;
        float s = 0.f, s2 = 0.f;
#pragma unroll
        for (int j = 0; j < 2; ++j)
#pragma unroll
          for (int w4 = 0; w4 < 4; ++w4) {
            const float lo = bflo(q[k][j][w4]), hi = bfhi(q[k][j][w4]);
            s += lo + hi; s2 += lo * lo + hi * hi;
          }
        s = wave_sum(s); s2 = wave_sum(s2);
        const float mu = s * (1.f / 1024.f);
        const float var = fmaxf(s2 * (1.f / 1024.f) - mu * mu, 0.f);
        const float rstd = rsqrtf(var + 1e-6f);
        if (lane == 0) st[i] = i < nvalid ? make_float2(mu, rstd) : make_float2(0.f, 0.f);
      }
    }
    __syncthreads();
    const int rr = tid >> 3, cc = tid & 7;
    u32x4 ld[4][4];
#pragma unroll
    for (int sl = 0; sl < 4; ++sl)
#pragma unroll
      for (int i4 = 0; i4 < 4; ++i4) {
        const int i = rr + 32 * i4;
        const int ic = i < nvalid ? i : 0;
        ld[sl][i4] = *(const u32x4*)(uv + (size_t)(rowbase + ic) * 2048 + 1024 + gq * 256 + sl * 64 + cc * 8);
      }
#pragma unroll
    for (int sl = 0; sl < 4; ++sl) {
      const int ch = gq * 256 + sl * 64 + cc * 8;
      const float4 g0 = *(const float4*)(lg + ch), g1 = *(const float4*)(lg + ch + 4);
      const float4 b0 = *(const float4*)(lb + ch), b1 = *(const float4*)(lb + ch + 4);
#pragma unroll
      for (int i4 = 0; i4 < 4; ++i4) {
        const int i = rr + 32 * i4;
        float o[8];
        if (i < nvalid) {
          const u32x4 q = ld[sl][i4];
          const float2 ms = st[i];
          o[0] = (bflo(q[0]) - ms.x) * ms.y * g0.x + b0.x; o[1] = (bfhi(q[0]) - ms.x) * ms.y * g0.y + b0.y;
          o[2] = (bflo(q[1]) - ms.x) * ms.y * g0.z + b0.z; o[3] = (bfhi(q[1]) - ms.x) * ms.y * g0.w + b0.w;
          o[4] = (bflo(q[2]) - ms.x) * ms.y * g1.x + b1.x; o[5] = (bfhi(q[2]) - ms.x) * ms.y * g1.y + b1.y;
          o[6] = (bflo(q[3]) - ms.x) * ms.y * g1.z + b1.z; o[7] = (bfhi(q[3]) - ms.x) * ms.y * g1.w + b1.w;
          if (c >= 128) {
            float* dst = p.out + OUT_SGUV + ((size_t)(e * 16 + (c - 128)) * 32 + i) * 1024 + ch;
            *(float4*)dst = make_float4(o[0], o[1], o[2], o[3]);
            *(float4*)(dst + 4) = make_float4(o[4], o[5], o[6], o[7]);
          }
        } else {
#pragma unroll
          for (int k = 0; k < 8; ++k) o[k] = 0.f;
        }
#pragma unroll
        for (int k = 0; k < 8; ++k) T[(cc * 8 + k) * 136 + i] = f2bf(o[k]);
      }
      __syncthreads();
#pragma unroll
      for (int j = 0; j < 4; ++j) {
        const int idx = tid + 256 * j;
        const int chl = idx >> 4, pc = idx & 15;
        const uint4 q = *(const uint4*)(T + chl * 136 + pc * 8);
        *(uint4*)(vT + ((size_t)c * 1024 + gq * 256 + sl * 64 + chl) * 128 + pc * 8) = q;
      }
      __syncthreads();
    }
  }
}

template <int W>
DI void pool_d_one(const u16* __restrict__ a, u16* __restrict__ d, const float* __restrict__ hist, int r, int ch0) {
  float acc[8];
#pragma unroll
  for (int k = 0; k < 8; ++k) acc[k] = 0.f;
  u32x4 q[W];
  float cnt;
  if (r < M_PROMPT) {
    const int t = r & 8191;
#pragma unroll
    for (int i = 0; i < W; ++i) q[i] = *(const u32x4*)(a + (size_t)(r - (i < t ? i : t)) * 1024 + ch0);
#pragma unroll
    for (int i = 0; i < W; ++i) {
      const float m = i <= t ? 1.f : 0.f;
      acc[0] += m * bflo(q[i][0]); acc[1] += m * bfhi(q[i][0]); acc[2] += m * bflo(q[i][1]); acc[3] += m * bfhi(q[i][1]);
      acc[4] += m * bflo(q[i][2]); acc[5] += m * bfhi(q[i][2]); acc[6] += m * bflo(q[i][3]); acc[7] += m * bfhi(q[i][3]);
    }
    cnt = (float)(t + 1 < W ? t + 1 : W);
  } else {
    const int rr = r - M_PROMPT, b = rr >> 5, s = rr & 31;
    f32x4 h[W][2];
#pragma unroll
    for (int i = 0; i < W; ++i) {
      q[i] = *(const u32x4*)(a + (size_t)(r - (i < s ? i : s)) * 1024 + ch0);
      const int hi = 15 + s - i;
      const float* hp = hist + ((size_t)b * 15 + (hi < 0 ? 0 : (hi > 14 ? 14 : hi))) * 1024 + ch0;
      h[i][0] = *(const f32x4*)hp; h[i][1] = *(const f32x4*)(hp + 4);
    }
#pragma unroll
    for (int i = 0; i < W; ++i) {
      const float m = i <= s ? 1.f : 0.f, mh = 1.f - m;
      acc[0] += m * bflo(q[i][0]) + mh * h[i][0][0]; acc[1] += m * bfhi(q[i][0]) + mh * h[i][0][1];
      acc[2] += m * bflo(q[i][1]) + mh * h[i][0][2]; acc[3] += m * bfhi(q[i][1]) + mh * h[i][0][3];
      acc[4] += m * bflo(q[i][2]) + mh * h[i][1][0]; acc[5] += m * bfhi(q[i][2]) + mh * h[i][1][1];
      acc[6] += m * bflo(q[i][3]) + mh * h[i][1][2]; acc[7] += m * bfhi(q[i][3]) + mh * h[i][1][3];
    }
    cnt = (float)W;
  }
  const float inv = 1.f / cnt;
  const u32x4 self = q[0];
  u32x4 o;
  o[0] = pk2(acc[0] * inv - bflo(self[0]), acc[1] * inv - bfhi(self[0]));
  o[1] = pk2(acc[2] * inv - bflo(self[1]), acc[3] * inv - bfhi(self[1]));
  o[2] = pk2(acc[4] * inv - bflo(self[2]), acc[5] * inv - bfhi(self[2]));
  o[3] = pk2(acc[6] * inv - bflo(self[3]), acc[7] * inv - bfhi(self[3]));
  *(u32x4*)(d + (size_t)r * 1024 + ch0) = o;
}

DI void pool_d_items(const Params& p, int e) {
  const u16* a = (const u16*)(p.ws + OFF_A);
  u16* d = (u16*)(p.ws + OFF_H);
  const float* hist = p.cache_pool + (size_t)e * 16 * 15 * 1024;
  const int tid = get_tid(), lane = tid & 63;
  for (int wi = get_bid() * 4 + (tid >> 6); wi < (M_TOK / 2) * 4; wi += gridDim.x * 4) {
    const int g = __builtin_amdgcn_readfirstlane(wi & 3);
    const int r = (wi >> 2) * 2 + (lane >> 5), ch0 = g * 256 + (lane & 31) * 8;
    if (g == 0) pool_d_one<2>(a, d, hist, r, ch0);
    else if (g == 1) pool_d_one<4>(a, d, hist, r, ch0);
    else if (g == 2) pool_d_one<8>(a, d, hist, r, ch0);
    else pool_d_one<16>(a, d, hist, r, ch0);
  }
}

DI void odd_rows(const Params& p, int o) {
  const int tid = get_tid(), lane = tid & 63;
  const float* zq = (const float*)(p.ws + OFF_ZQ);
  u16* qn = (u16*)(p.ws + OFF_QN);
  u16* ckvb = (u16*)(p.ws + OFF_CKVB);
  u16* krb = (u16*)(p.ws + OFFB_KROPEB);
  const float2* rope = (const float2*)(p.ws + OFFB_ROPE);
  const float* qnw = p.q_norm + o * 384;
  const float* kvw = p.kv_norm + o * 256;
  for (int r = get_bid() * 4 + (tid >> 6); r < M_TOK; r += gridDim.x * 4) {
    const float* z = zq + (size_t)r * 704;
    float2 qv[3]; float ss = 0.f;
#pragma unroll
    for (int i = 0; i < 3; ++i) { qv[i] = *(const float2*)(z + lane * 2 + 128 * i); ss += qv[i].x * qv[i].x + qv[i].y * qv[i].y; }
    const float4 kv = *(const float4*)(z + 384 + lane * 4);
    float sk = kv.x * kv.x + kv.y * kv.y + kv.z * kv.z + kv.w * kv.w;
    const float kr = z[640 + lane];
    ss = wave_sum(ss); sk = wave_sum(sk);
    const float rq = rsqrtf(ss * (1.f / 384.f) + 1e-6f);
    const float rk = rsqrtf(sk * (1.f / 256.f) + 1e-6f);
#pragma unroll
    for (int i = 0; i < 3; ++i) {
      const float2 w = *(const float2*)(qnw + lane * 2 + 128 * i);
      *(unsigned*)(qn + (size_t)r * 384 + lane * 2 + 128 * i) = pk2(qv[i].x * rq * w.x, qv[i].y * rq * w.y);
    }
    size_t kvrow; float *dck, *dkr; int pos;
    if (r < M_PROMPT) {
      kvrow = r; pos = r & 8191;
      dck = p.out + OUT_CKVP + ((size_t)o * 16384 + r) * 256;
      dkr = p.out + OUT_KRP + ((size_t)o * 16384 + r) * 64;
    } else {
      const int rr = r - M_PROMPT, b = rr >> 5, s = rr & 31;
      kvrow = (size_t)M_PROMPT + b * KSTR_S + 1024 + s; pos = 1024 + s;
      dck = p.out + OUT_CKVS + ((size_t)o * 512 + rr) * 256;
      dkr = p.out + OUT_KRS + ((size_t)o * 512 + rr) * 64;
    }
    const float4 w4 = *(const float4*)(kvw + lane * 4);
    const float c0 = kv.x * rk * w4.x, c1 = kv.y * rk * w4.y, c2 = kv.z * rk * w4.z, c3 = kv.w * rk * w4.w;
    *(float4*)(dck + lane * 4) = make_float4(c0, c1, c2, c3);
    st_bf4(ckvb + kvrow * 256 + lane * 4, c0, c1, c2, c3);
    const float other = __shfl_xor(kr, 32, 64);
    const float2 cs = rope[pos * 32 + (lane & 31)];
    const float ro = lane < 32 ? kr * cs.x - other * cs.y : kr * cs.x + other * cs.y;
    dkr[lane] = ro;
    krb[kvrow * 64 + lane] = f2bf(ro);
  }
  const int gt = get_bid() * 256 + tid, gs = gridDim.x * 256;
  const float* cck = p.cache_ckv + (size_t)o * 16 * 1024 * 256;
  const float* ckr = p.cache_krope + (size_t)o * 16 * 1024 * 64;
  for (int idx = gt; idx < 524288; idx += gs) {
    const int b = idx >> 15, rem = idx & 32767, k = rem >> 5, c8 = (rem & 31) * 8;
    const float* s = cck + ((size_t)(b * 1024 + k)) * 256 + c8;
    const float4 a0 = *(const float4*)s, a1 = *(const float4*)(s + 4);
    *(uint4*)(ckvb + ((size_t)M_PROMPT + b * KSTR_S + k) * 256 + c8) = make_uint4(pk2(a0.x, a0.y), pk2(a0.z, a0.w), pk2(a1.x, a1.y), pk2(a1.z, a1.w));
  }
  for (int idx = gt; idx < 131072; idx += gs) {
    const int b = idx >> 13, rem = idx & 8191, k = rem >> 3, c8 = (rem & 7) * 8;
    const float* s = ckr + ((size_t)(b * 1024 + k)) * 64 + c8;
    const float4 a0 = *(const float4*)s, a1 = *(const float4*)(s + 4);
    *(uint4*)(krb + ((size_t)M_PROMPT + b * KSTR_S + k) * 64 + c8) = make_uint4(pk2(a0.x, a0.y), pk2(a0.z, a0.w), pk2(a1.x, a1.y), pk2(a1.z, a1.w));
  }
  const unsigned zu = __float_as_uint(zero_f());
  for (int idx = gt; idx < 16 * 96 * 32; idx += gs) {
    const int b = idx / 3072, rem = idx % 3072, k = 1056 + (rem >> 5), c8 = (rem & 31) * 8;
    *(uint4*)(ckvb + ((size_t)M_PROMPT + b * KSTR_S + k) * 256 + c8) = make_uint4(zu, zu, zu, zu);
  }
  for (int idx = gt; idx < 16 * 96 * 8; idx += gs) {
    const int b = idx / 768, rem = idx % 768, k = 1056 + (rem >> 3), c8 = (rem & 7) * 8;
    *(uint4*)(krb + ((size_t)M_PROMPT + b * KSTR_S + k) * 64 + c8) = make_uint4(zu, zu, zu, zu);
  }
}

DI void attn_item(const u16* __restrict__ qbuf, const u16* __restrict__ knope, const u16* __restrict__ krope,
                  const u16* __restrict__ vt, long vt_ld, u16* __restrict__ ao, int head, int qrow0, int nwaves,
                  long kvrow0, int ntiles, int tiles_lo, int nkeys, char* smem, bool dry) {
  const int tid = get_tid();
  const int lane = tid & 63, wave = tid >> 6;
  const int l31 = lane & 31, h2 = lane >> 5;
  const bool active = wave < nwaves;
  const int my_tiles = wave < 2 ? tiles_lo : ntiles;
  const int qrow = qrow0 + wave * 32 + l31;
  const int rsw = (l31 >> 1) & 7;
  int koff[4];
#pragma unroll
  for (int c4 = 0; c4 < 4; ++c4) koff[c4] = l31 * 128 + (((2 * c4 + h2) ^ rsw) << 4);
  bf16x8 qf[12];
  if (active) {
    const u16* qp = qbuf + (size_t)qrow * 1536 + head * 192 + h2 * 8;
#pragma unroll
    for (int ks = 0; ks < 12; ++ks) qf[ks] = *(const bf16x8*)(qp + ks * 16);
  } else {
#pragma unroll
    for (int ks = 0; ks < 12; ++ks) qf[ks] = (bf16x8){0, 0, 0, 0, 0, 0, 0, 0};
  }
#pragma unroll
  for (int ks = 0; ks < 12; ++ks) asm volatile("" : "+v"(qf[ks]));
  f32x16 oacc[4];
  { const float z = zero_f();
#pragma unroll
  for (int i = 0; i < 4; ++i)
#pragma unroll
    for (int j = 0; j < 16; ++j) oacc[i][j] = z; }
  float m_run = -INFINITY, l_run = 0.f;

  const int wu = __builtin_amdgcn_readfirstlane(wave);
  const unsigned sbase = (unsigned)__builtin_amdgcn_readfirstlane((int)(unsigned)(size_t)smem);
  const int r8 = lane >> 3, c0 = (lane & 7) ^ (r8 >> 1);
  const unsigned ce = (unsigned)(c0 << 3), co = (unsigned)((c0 ^ 4) << 3);
  unsigned ko = (unsigned)((kvrow0 + (wu & 1) * 32 + r8) * 1024 + head * 128 + (wu >> 1) * 64);
  unsigned ro = (unsigned)((kvrow0 + wu * 16 + r8) * 64);
  unsigned vo = (unsigned)((head * 128 + wu * 32 + r8) * vt_ld);
  const unsigned vld8 = (unsigned)vt_ld * 8u;
  const unsigned kdst = sbase + (wu >> 1) * 8192 + (wu & 1) * 4096;
  const unsigned rdst = sbase + 16384 + wu * 2048;
  const unsigned vdst = sbase + 24576 + wu * 4096;
#define ATT_DMA(BUFOFF)                                                                                        \
  {                                                                                                            \
    _Pragma("unroll") for (int i = 0; i < 4; ++i) dma16(knope + (ko + (unsigned)i * 8192u + ((i & 1) ? co : ce)), kdst + (BUFOFF) + i * 1024); \
    _Pragma("unroll") for (int i = 0; i < 2; ++i) dma16(krope + (ro + (unsigned)i * 512u + ((i & 1) ? co : ce)), rdst + (BUFOFF) + i * 1024);   \
    _Pragma("unroll") for (int i = 0; i < 4; ++i) dma16(vt + (vo + (unsigned)i * vld8 + ((i & 1) ? co : ce)), vdst + (BUFOFF) + i * 1024);      \
    ko += 65536u; ro += 4096u; vo += 64u;                                                                      \
  }
  __syncthreads();
  ATT_DMA(0u)
  for (int kt = 0; kt < ntiles; ++kt) {
    asm volatile("s_waitcnt vmcnt(0)" ::: "memory");
    __syncthreads();
    if (kt + 1 < ntiles) ATT_DMA((unsigned)((kt + 1) & 1) * 40960u)
    if (active && kt < my_tiles) {
      const char* cur = smem + (kt & 1) * 40960;
      f32x16 st[2];
      __builtin_amdgcn_s_setprio(1);
#pragma unroll
      for (int mt = 0; mt < 2; ++mt) {
#pragma unroll
        for (int j = 0; j < 16; ++j) st[mt][j] = 0.f;
        bf16x8 kf[12];
#pragma unroll
        for (int ks = 0; ks < 12; ++ks) kf[ks] = *(const bf16x8*)(cur + koff[ks & 3] + (ks >> 2) * 8192 + mt * 4096);
        asm volatile("" : "+v"(kf[0]), "+v"(kf[1]), "+v"(kf[2]), "+v"(kf[3]), "+v"(kf[4]), "+v"(kf[5]));
#pragma unroll
        for (int ks = 0; ks < 6; ++ks) st[mt] = __builtin_amdgcn_mfma_f32_32x32x16_bf16(kf[ks], qf[ks], st[mt], 0, 0, 0);
        asm volatile("" : "+v"(kf[6]), "+v"(kf[7]), "+v"(kf[8]), "+v"(kf[9]), "+v"(kf[10]), "+v"(kf[11]));
#pragma unroll
        for (int ks = 6; ks < 12; ++ks) st[mt] = __builtin_amdgcn_mfma_f32_32x32x16_bf16(kf[ks], qf[ks], st[mt], 0, 0, 0);
      }
      __builtin_amdgcn_s_setprio(0);
      if (kt * 64 + 64 > nkeys) {
#pragma unroll
        for (int mt = 0; mt < 2; ++mt)
#pragma unroll
          for (int j = 0; j < 16; ++j) {
            const int key = kt * 64 + mt * 32 + (j & 3) + 8 * (j >> 2) + 4 * h2;
            if (key >= nkeys) st[mt][j] = -INFINITY;
          }
      }
      float mx = fmaxf(st[0][0], st[1][0]);
#pragma unroll
      for (int j = 1; j < 16; ++j) mx = fmaxf(mx, fmaxf(st[0][j], st[1][j]));
      mx = fmaxf(mx, __shfl_xor(mx, 32, 64));
      const float m_new = (mx > m_run + 8.f) ? mx : m_run;
      const float alpha = __builtin_amdgcn_exp2f(m_run - m_new);
      m_run = m_new;
      float ps = 0.f;
#pragma unroll
      for (int mt = 0; mt < 2; ++mt)
#pragma unroll
        for (int j = 0; j < 16; ++j) { const float pv = __builtin_amdgcn_exp2f(st[mt][j] - m_new); st[mt][j] = pv; ps += pv; }
      l_run = l_run * alpha + ps;
      if (__any(alpha != 1.f)) {
#pragma unroll
        for (int i = 0; i < 4; ++i)
#pragma unroll
          for (int j = 0; j < 16; ++j) oacc[i][j] *= alpha;
      }
#pragma unroll
      for (int mt = 0; mt < 2; ++mt)
#pragma unroll
        for (int s = 0; s < 2; ++s) {
          union { bf16x8 v; unsigned u[4]; } pf;
#pragma unroll
          for (int k = 0; k < 4; ++k) pf.u[k] = pk2(st[mt][8 * s + 2 * k], st[mt][8 * s + 2 * k + 1]);
          __builtin_amdgcn_s_setprio(1);
#pragma unroll
          for (int vt4 = 0; vt4 < 4; ++vt4) {
            const bf16x8 vf = *(const bf16x8*)(cur + 24576 + koff[mt * 2 + s] + vt4 * 4096);
            oacc[vt4] = __builtin_amdgcn_mfma_f32_32x32x16_bf16(vf, pf.v, oacc[vt4], 0, 0, 0);
          }
          __builtin_amdgcn_s_setprio(0);
        }
    }
  }
#undef ATT_DMA
  const float lt_probe = l_run + oacc[0][0] + oacc[1][5] + oacc[2][9] + oacc[3][15];
  if (active && (!dry || lt_probe == 123456.789f)) {
    const float lt = l_run + __shfl_xor(l_run, 32, 64);
    const float inv = 1.f / lt;
    u16* op = ao + (size_t)qrow * 1024 + head * 128 + 4 * h2;
#pragma unroll
    for (int vt4 = 0; vt4 < 4; ++vt4)
#pragma unroll
      for (int a = 0; a < 4; ++a) {
        u16* q = op + vt4 * 32 + 8 * a;
        const uint2 gt = *(const uint2*)q;
        st_bf4(q, oacc[vt4][4 * a] * inv * bflo(gt.x), oacc[vt4][4 * a + 1] * inv * bfhi(gt.x),
               oacc[vt4][4 * a + 2] * inv * bflo(gt.y), oacc[vt4][4 * a + 3] * inv * bfhi(gt.y));
      }
  }
}

DI void attn_phase(const Params& p, char* smem, bool dry) {
  const u16* qbuf = (const u16*)(p.ws + OFF_ZQ);
  const u16* knope = (const u16*)(p.ws + OFF_KN);
  const u16* krb = (const u16*)(p.ws + OFFB_KROPEB);
  const u16* vtb = (const u16*)(p.ws + OFF_VTO);
  u16* ao = (u16*)(p.ws + OFF_GO);
  for (int it = get_bid(); it < 640; it += gridDim.x) {
    if (it < 512) {
      const int bh = (it & 7) * 2 + ((it >> 3) & 1), qp = it >> 4;
      const int b = bh >> 3, h = bh & 7;
      const u16* vt = vtb + (size_t)b * 1024 * 8192;
#pragma unroll 1
      for (int half = 0; half < 2; ++half) {
        const int qb = half == 0 ? 63 - qp : qp;
        attn_item(qbuf, knope, krb, vt, 8192, ao, h, b * 8192 + qb * 128, 4, (long)b * 8192, 2 * qb + 2, 2 * qb + 1,
                  (2 * qb + 2) * 64, smem, dry);
      }
    } else {
      const int s = it - 512, b = s >> 3, h = s & 7;
      const u16* vt = vtb + (size_t)2 * 1024 * 8192 + (size_t)b * 1024 * KSTR_S;
      attn_item(qbuf, knope, krb, vt, KSTR_S, ao, h, M_PROMPT + b * 32, 1, (long)M_PROMPT + (long)b * KSTR_S, 17, 17, 1056, smem, dry);
    }
  }
  __syncthreads();
  if (get_tid() == 0) { const unsigned zu = __float_as_uint(zero_f()); *(uint4*)(smem + 81904) = make_uint4(zu, zu, zu, zu); }
}

#define XB_TMO      128
#define XB_XCNT(j)  (256  + 64 * (j))
#define XB_XSUB(j)  (1280 + 64 * (j))
#define XB_XGEN(j)  (2304 + 64 * (j))
#define XB_TOP      3328
#define XB_TOPGEN   3392
#define XCD_BAR_WORDS 3456
#define XB_SPIN_CAP (1u << 20)
#define LAS __attribute__((address_space(3)))
constexpr size_t OFFB_BAR = 16000000;

DI unsigned xb_ld(unsigned* p) { return __hip_atomic_load(p, __ATOMIC_RELAXED, __HIP_MEMORY_SCOPE_AGENT); }
DI unsigned xb_add(unsigned* p, unsigned v) { return __hip_atomic_fetch_add(p, v, __ATOMIC_RELAXED, __HIP_MEMORY_SCOPE_AGENT); }
DI unsigned xb_xcc_id() { return (unsigned)__builtin_amdgcn_s_getreg((3 << 11) | 20) & 0xFu; }
#define XB_SPIN(cond, bar) do { unsigned _sp = 0; while (cond) { __builtin_amdgcn_s_sleep(1); \
    if ((++_sp & 255u) == 0u) { if (xb_ld(&(bar)[XB_TMO])) break; if (_sp > XB_SPIN_CAP) { atomicAdd(&(bar)[XB_TMO], 1u); break; } } } } while (0)

struct XcdBarrier { unsigned* bar; unsigned x; volatile LAS unsigned* st; };

DI XcdBarrier xcd_barrier_post(unsigned* bar, volatile LAS unsigned* st) {
  XcdBarrier b; b.bar = bar; b.x = xb_xcc_id(); b.st = st;
  if (threadIdx.x == 0) (void)xb_add(&bar[XB_XCNT(b.x)], 1u);
  return b;
}
DI void xcd_barrier_complete(unsigned* bar, unsigned x, unsigned& nloc, unsigned& nx) {
  const unsigned G = gridDim.x * gridDim.y * gridDim.z;
  unsigned sum, cnt, mine, sp = 0u;
  for (;;) {
    sum = 0u; cnt = 0u; mine = 0u;
#pragma unroll
    for (unsigned j = 0; j < 16; ++j) { const unsigned c = xb_ld(&bar[XB_XCNT(j)]); sum += c; cnt += (c > 0u) ? 1u : 0u; mine = (j == x) ? c : mine; }
    if (sum == G) break;
    __builtin_amdgcn_s_sleep(1);
    if ((++sp & 255u) == 0u) { if (xb_ld(&bar[XB_TMO])) break; if (sp > XB_SPIN_CAP) { atomicAdd(&bar[XB_TMO], 1u); break; } }
  }
  nloc = mine > 0u ? mine : 1u; nx = cnt > 0u ? cnt : 1u;
}
DI void xcd_barrier(const XcdBarrier& b) {
  asm volatile("s_waitcnt vmcnt(0)" ::: "memory");
  __syncthreads();
  if (threadIdx.x == 0) {
    unsigned* bar = b.bar;
    __builtin_amdgcn_s_waitcnt(0);
    unsigned nloc = b.st[0], nx = b.st[1];
    if (nloc == 0u) { xcd_barrier_complete(bar, b.x, nloc, nx); b.st[0] = nloc; b.st[1] = nx; }
    const unsigned old = xb_add(&bar[XB_XSUB(b.x)], 1u);
    const unsigned gen = old / nloc;
    if (old + 1u == (gen + 1u) * nloc) {
      __builtin_amdgcn_fence(__ATOMIC_RELEASE, "agent");
      asm volatile("s_waitcnt vmcnt(0)" ::: "memory");
      const unsigned og = xb_add(&bar[XB_TOP], 1u);
      const unsigned tg = og / nx;
      if (og + 1u == (tg + 1u) * nx) xb_add(&bar[XB_TOPGEN], 1u);
      else XB_SPIN(xb_ld(&bar[XB_TOPGEN]) == tg, bar);
      __builtin_amdgcn_fence(__ATOMIC_ACQUIRE, "agent");
      xb_add(&bar[XB_XGEN(b.x)], 1u);
      asm volatile("s_waitcnt vmcnt(0)" ::: "memory");
    } else {
      XB_SPIN(xb_ld(&bar[XB_XGEN(b.x)]) == gen, bar);
      __builtin_amdgcn_fence(__ATOMIC_ACQUIRE, "agent");
      asm volatile("s_waitcnt vmcnt(0)" ::: "memory");
    }
  }
  __syncthreads();
}

DI void phase_even(const Params& p, int e, int sub, char* smem) {
  const int layer = 2 * e;
  u16* W = (u16*)(p.ws + OFF_W);
  u16* hbuf = (u16*)(p.ws + OFF_H);
  u16* abuf = (u16*)(p.ws + OFF_A);
  u16* uvbuf = (u16*)(p.ws + OFF_UV);
  u16* gbuf = (u16*)(p.ws + OFF_GATE);
  u16* vT = (u16*)(p.ws + OFF_VTE);
  if (sub == 0) {
    EpiE1 epi{abuf, uvbuf, gbuf, p.out + OUT_SPP + (size_t)e * 2 * 15 * 1024, p.out + OUT_SPS + (size_t)e * 16 * 15 * 1024};
    bool pre = false;
    for (int t = get_bid(); t < 132 * 40; t += gridDim.x) {
      const int tm = t / 40, tn = t % 40;
      const int t2 = t + gridDim.x, tm2 = t2 / 40, tn2 = t2 % 40;
      const bool nx = t2 < 132 * 40;
      gemm_tile<4>(hbuf + (size_t)tm * 128 * 1024, 1024, W + WE_IN + (size_t)tn * 128 * 1024, 1024, 1024, smem, tm * 128, tn * 128, epi, pre,
                   nx ? hbuf + (size_t)tm2 * 128 * 1024 : nullptr, W + WE_IN + (size_t)tn2 * 128 * 1024);
      pre = nx;
    }
  } else if (sub == 1) {
    sgu_ln_items(p, e, smem);
    pool_d_items(p, e);
  } else if (sub == 2) {
    for (int t = get_bid(); t < 1056 + 1152; t += gridDim.x) {
      if (t < 1056) {
        const int g = t / 264, r = t % 264, tm = r >> 1, tn = r & 1;
        EpiPool epi{p.pool_scale + e * 1024, gbuf, g};
        gemm_tile<4>(hbuf + (size_t)tm * 128 * 1024 + g * 256, 1024, W + WE_POOL + (size_t)g * 65536 + (size_t)tn * 128 * 256, 256, 256, smem,
                     tm * 128, tn * 128, epi);
      } else {
        const int u = t - 1056, c = u >> 3, g = (u >> 1) & 3, tn = u & 1;
        EpiSgu epi{p.b_spatial + (e * 4 + g) * 128, uvbuf, gbuf, g, c < 128 ? c * 128 : M_PROMPT + (c - 128) * 32, c < 128 ? 128 : 32};
        gemm_tile<4>(W + WE_WS + (size_t)g * 16384, 128, vT + ((size_t)c * 1024 + g * 256 + tn * 128) * 128, 128, 128, smem, 0, tn * 128, epi);
      }
    }
  } else if (sub == 3) {
    EpiBF16 epi{(u16*)(p.ws + OFF_UV), 1024};
    for (int t = get_bid(); t < 512 + 64; t += gridDim.x) {
      if (t < 512) {
        const int tm = t >> 3, tn = t & 7;
        gemm_dma<256>(gbuf + (size_t)tm * 256 * 2048, 2048, W + WE_OUT + (size_t)tn * 128 * 2048, 2048, 2048, smem, tm * 256, tn * 128, epi);
      } else {
        const int u = t - 512, tm = u >> 3, tn = u & 7, m0 = M_PROMPT + tm * 64;
        gemm_tile<2>(gbuf + (size_t)m0 * 2048, 2048, W + WE_OUT + (size_t)tn * 128 * 2048, 2048, 2048, smem, m0, tn * 128, epi);
      }
    }
  } else {
    resid_norm(p, layer, (const u16*)(p.ws + OFF_UV));
    convert_weights(p, layer + 1, smem);
  }
}

DI void knope_tile(const Params& p, int u, char* smem) {
  const u16* W = (const u16*)(p.ws + OFF_W);
  const u16* ckvb = (const u16*)(p.ws + OFF_CKVB);
  EpiBF16 ek{(u16*)(p.ws + OFF_KN), 1024};
  const int tm = u >> 3, tn = u & 7;
  gemm_dma<256>(ckvb + (size_t)tm * 256 * 256, 256, W + WO_KV + (size_t)tn * 128 * 256, 256, 256, smem, tm * 256, tn * 128, ek);
}

DI void phase_odd(const Params& p, int o, int sub, char* smem) {
  const int layer = 2 * o + 1;
  u16* W = (u16*)(p.ws + OFF_W);
  u16* hbuf = (u16*)(p.ws + OFF_H);
  u16* ckvb = (u16*)(p.ws + OFF_CKVB);
  if (sub == 0) {
    EpiO1 epi{(float*)(p.ws + OFF_ZQ), (u16*)(p.ws + OFF_GO)};
    bool pre = false;
    for (int t = get_bid(); t < 132 * 14; t += gridDim.x) {
      const int tm = t / 14, tn = t % 14;
      const int t2 = t + gridDim.x, tm2 = t2 / 14, tn2 = t2 % 14;
      const bool nx = t2 < 132 * 14;
      gemm_tile<4>(hbuf + (size_t)tm * 128 * 1024, 1024, W + WO_IN + (size_t)tn * 128 * 1024, 1024, 1024, smem, tm * 128, tn * 128, epi, pre,
                   nx ? hbuf + (size_t)tm2 * 128 * 1024 : nullptr, W + WO_IN + (size_t)tn2 * 128 * 1024);
      pre = nx;
    }
  } else if (sub == 1) {
    odd_rows(p, o);
  } else if (sub == 2) {
    EpiQup eq{(const float2*)(p.ws + OFFB_ROPE), (u16*)(p.ws + OFF_ZQ)};
    const u16* qn = (const u16*)(p.ws + OFF_QN);
    bool pre = false;
    for (int t = get_bid(); t < 1584 + 256; t += gridDim.x) {
      if (t < 1584) {
        const int tm = t / 12, tn = t % 12;
        const int t2 = t + gridDim.x, tm2 = t2 / 12, tn2 = t2 % 12;
        const bool nx = t2 < 1584;
        gemm_tile<4>(qn + (size_t)tm * 128 * 384, 384, W + WO_Q + (size_t)tn * 128 * 384, 384, 384, smem, tm * 128, tn * 128, eq, pre,
                     nx ? qn + (size_t)tm2 * 128 * 384 : nullptr, W + WO_Q + (size_t)tn2 * 128 * 384);
        pre = nx;
      } else {
        knope_tile(p, t - 1584, smem);
      }
    }
  } else if (sub == 3) {
    u16* vtb = (u16*)(p.ws + OFF_VTO);
    for (int t = get_bid(); t < 1088 + 832; t += gridDim.x) {
      if (t < 1088) {
        int b, tm, tn; long kv0, ld; u16* C;
        if (t < 512) { b = t >> 8; const int r = t & 255; tm = r >> 6; tn = r & 63; kv0 = (long)b * 8192; ld = 8192; C = vtb + (size_t)b * 1024 * 8192; }
        else { const int u = t - 512; b = u / 36; const int r = u % 36; tm = r / 9; tn = r % 9; kv0 = (long)M_PROMPT + (long)b * KSTR_S; ld = KSTR_S;
               C = vtb + (size_t)2 * 1024 * 8192 + (size_t)b * 1024 * KSTR_S; }
        EpiVT ev{C, ld};
        gemm_dma<256>(W + WO_KV + (size_t)(1024 + tm * 256) * 256, 256, ckvb + (size_t)(kv0 + tn * 128) * 256, 256, 256, smem, tm * 256, tn * 128, ev);
      } else {
        knope_tile(p, 256 + (t - 1088), smem);
      }
    }
  } else if (sub == 4) {
#if PROBE_ATTN
    attn_phase(p, smem, true);
#endif
    attn_phase(p, smem, false);
  } else if (sub == 5) {
    EpiBF16 epi{(u16*)(p.ws + OFF_KN), 1024};
    const u16* ao = (const u16*)(p.ws + OFF_GO);
    for (int t = get_bid(); t < 512 + 64; t += gridDim.x) {
      if (t < 512) {
        const int tm = t >> 3, tn = t & 7;
        gemm_dma<256>(ao + (size_t)tm * 256 * 1024, 1024, W + WO_O + (size_t)tn * 128 * 1024, 1024, 1024, smem, tm * 256, tn * 128, epi);
      } else {
        const int u = t - 512, tm = u >> 3, tn = u & 7, m0 = M_PROMPT + tm * 64;
        gemm_tile<2>(ao + (size_t)m0 * 1024, 1024, W + WO_O + (size_t)tn * 128 * 1024, 1024, 1024, smem, m0, tn * 128, epi);
      }
    }
  } else {
    resid_norm(p, layer, (const u16*)(p.ws + OFF_KN));
    if (layer < 3) convert_weights(p, layer + 1, smem);
  }
}

DI void run_phase(const Params& p, int ph, char* smem) {
  if (ph == 0) { convert_weights(p, 0, smem); prenorm0(p); }
  else if (ph <= 5) phase_even(p, 0, ph - 1, smem);
  else if (ph <= 12) phase_odd(p, 0, ph - 6, smem);
  else if (ph <= 17) phase_even(p, 1, ph - 13, smem);
  else phase_odd(p, 1, ph - 18, smem);
}

#if !USE_COOP
__global__ void __launch_bounds__(256, 2) k_phase(Params p, int ph) {
  __shared__ __attribute__((aligned(16))) char smem[81920];
  run_phase(p, ph, smem);
}
#endif

#if USE_COOP
__global__ void __launch_bounds__(256, 2) k_mega(Params p) {
  __shared__ __attribute__((aligned(16))) char smem[81920];
  cg::grid_group grid = cg::this_grid();
  if (threadIdx.x == 0) *(uint4*)(smem + 81904) = make_uint4(0u, 0u, 0u, 0u);
  __syncthreads();
  XcdBarrier xb = xcd_barrier_post((unsigned*)(p.ws + OFFB_BAR), (volatile LAS unsigned*)(smem + 81904));
#pragma unroll 1
  for (int ph = 0; ph < NPHASE; ++ph) {
    run_phase(p, ph, smem);
    if (ph + 1 < NPHASE) xcd_barrier(xb);
    if (p.out == nullptr) grid.sync();
  }
}
#endif

extern "C" void kernel_launch(void* const* d_in, const int* in_sizes, int n_in, void* d_out, int out_size, void* d_ws,
                              size_t ws_size, hipStream_t stream) {
  (void)in_sizes; (void)n_in; (void)out_size;
  if (ws_size < 268435456ull) { fprintf(stderr, "ws too small: %zu\n", ws_size); return; }
  Params p{};
  p.x_prompt = (const float*)d_in[0]; p.x_sample = (const float*)d_in[1]; p.cache_pool = (const float*)d_in[2];
  p.cache_ckv = (const float*)d_in[3]; p.cache_krope = (const float*)d_in[4]; p.norm_pre = (const float*)d_in[5];
  p.norm_post = (const float*)d_in[6]; p.w_in_even = (const float*)d_in[7]; p.w_pool = (const float*)d_in[8];
  p.pool_scale = (const float*)d_in[9]; p.sgu_ln_g = (const float*)d_in[10]; p.sgu_ln_b = (const float*)d_in[11];
  p.w_spatial = (const float*)d_in[12]; p.b_spatial = (const float*)d_in[13]; p.w_out_even = (const float*)d_in[14];
  p.w_in_odd = (const float*)d_in[15]; p.q_norm = (const float*)d_in[16]; p.kv_norm = (const float*)d_in[17];
  p.w_q_up = (const float*)d_in[18]; p.w_kv_up = (const float*)d_in[19]; p.w_o = (const float*)d_in[20];
  p.out = (float*)d_out; p.ws = (char*)d_ws;
#if USE_COOP
  static int grid_blocks = 0;
  if (!grid_blocks) {
    int dev = 0, cus = 0, per_cu = 0;
    (void)hipGetDevice(&dev);
    (void)hipDeviceGetAttribute(&cus, hipDeviceAttributeMultiprocessorCount, dev);
    (void)hipOccupancyMaxActiveBlocksPerMultiprocessor(&per_cu, k_mega, 256, 0);
    if (per_cu > 2) per_cu = 2;
    if (per_cu < 1) per_cu = 1;
    grid_blocks = cus * per_cu;
  }
  (void)hipMemsetAsync((char*)d_ws + OFFB_BAR, 0, XCD_BAR_WORDS * 4, stream);
  void* args[] = {&p};
  hipError_t e = hipLaunchCooperativeKernel((void*)k_mega, dim3(grid_blocks), dim3(256), args, 0, stream);
  if (e != hipSuccess) fprintf(stderr, "cooperative launch failed: %s (grid %d)\n", hipGetErrorString(e), grid_blocks);
#else
  for (int ph = 0; ph < NPHASE; ++ph) hipLaunchKernelGGL(k_phase, dim3(512), dim3(256), 0, stream, p, ph);
#endif
}
```

```cpp
#include <hip/hip_runtime.h>
#include <hip/hip_cooperative_groups.h>
#include <cstdio>
namespace cg = cooperative_groups;

typedef unsigned short u16;
using bf16x8 = __attribute__((ext_vector_type(8))) short;
using f32x4 = __attribute__((ext_vector_type(4))) float;
using f32x16 = __attribute__((ext_vector_type(16))) float;
using u32x4 = __attribute__((ext_vector_type(4))) unsigned;
using u32x2 = __attribute__((ext_vector_type(2))) unsigned;
#define DI __device__ __forceinline__

#ifndef USE_COOP
#define USE_COOP 1
#endif
#ifndef PROBE_ATTN
#define PROBE_ATTN 0
#endif
#ifndef PROBE_GEMM
#define PROBE_GEMM 0
#endif

constexpr int M_TOK = 16896;
constexpr int M_PROMPT = 16384;
constexpr int KSTR_S = 1152;
constexpr int KVR = 16384 + 16 * KSTR_S;
constexpr int NPHASE = 25;
constexpr float QSCALE = 0.07216878364870322f * 1.4426950408889634f;

constexpr size_t OFF_W = 0;
constexpr size_t OFF_H = 16777216;
constexpr size_t SZ_H = 34603008;
constexpr size_t OFF_A = OFF_H + SZ_H;
constexpr size_t OFF_UV = OFF_A + SZ_H;
constexpr size_t OFF_GATE = OFF_UV + 69206016;
constexpr size_t OFF_VTE = OFF_GATE + 69206016;
constexpr size_t OFF_CKVB = OFF_H;
constexpr size_t OFF_QN = OFF_H + 17825792;
constexpr size_t OFF_VTO = OFF_QN;
constexpr size_t OFF_ZQ = OFF_VTO + 71303168;
constexpr size_t OFF_GO = OFF_ZQ + 51904512;
constexpr size_t OFF_KN = OFF_GO + 34603008;
constexpr size_t WS_NEED = OFF_KN + 71303168;
static_assert(WS_NEED <= 268435456, "ws");
static_assert(OFF_VTE + 37748736 <= 268435456, "ws");
constexpr size_t WE_IN = 0, WE_OUT = 5242880, WE_POOL = 7340032, WE_WS = 7602176;
constexpr size_t WO_IN = 0, WO_Q = 1835008, WO_KV = 2424832, WO_O = 2949120;
constexpr size_t OFFB_ROPE = 7995392, OFFB_KROPEB = 10092544;
constexpr size_t OUT_SPP = 17301504, OUT_SPS = 17362944, OUT_SGUV = 17854464, OUT_CKVP = 18903040,
                 OUT_KRP = 27291648, OUT_CKVS = 29388800, OUT_KRS = 29650944;

struct Params {
  const float *x_prompt, *x_sample, *cache_pool, *cache_ckv, *cache_krope, *norm_pre, *norm_post,
      *w_in_even, *w_pool, *pool_scale, *sgu_ln_g, *sgu_ln_b, *w_spatial, *b_spatial, *w_out_even,
      *w_in_odd, *q_norm, *kv_norm, *w_q_up, *w_kv_up, *w_o;
  float* out;
  char* ws;
};

DI int get_tid() { int t = threadIdx.x; asm volatile("" : "+v"(t)); return t; }
DI int get_bid() { int b = blockIdx.x; asm volatile("" : "+s"(b)); return b; }
DI float zero_f() { float z = 0.f; asm volatile("" : "+v"(z)); return z; }
DI u16 f2bf(float x) { unsigned u = __float_as_uint(x); u += 0x7fffu + ((u >> 16) & 1u); return (u16)(u >> 16); }
DI float bf2f(u16 v) { return __uint_as_float(((unsigned)v) << 16); }
typedef __bf16 bf16x2_t __attribute__((ext_vector_type(2)));
typedef float f32x2_t __attribute__((ext_vector_type(2)));
DI unsigned pk2(float a, float b) { f32x2_t f = {a, b}; return __builtin_bit_cast(unsigned, __builtin_convertvector(f, bf16x2_t)); }
DI float bflo(unsigned u) { return __uint_as_float(u << 16); }
DI float bfhi(unsigned u) { return __uint_as_float(u & 0xffff0000u); }
DI float wave_sum(float v) {
#pragma unroll
  for (int o = 32; o; o >>= 1) v += __shfl_xor(v, o, 64);
  return v;
}
DI float gelu_f(float x) { return 0.5f * x * (1.f + erff(x * 0.70710678118654752f)); }
DI float silu_f(float x) { return x * __builtin_amdgcn_rcpf(1.f + __expf(-x)); }
DI int tok_pos(int m) { return m < M_PROMPT ? (m & 8191) : 1024 + ((m - M_PROMPT) & 31); }

DI void dma16(const void* gsrc, unsigned lds_dst) {
  unsigned keep;
  asm volatile("s_mov_b32 %0, m0\n\ts_mov_b32 m0, %2\n\ts_nop 0\n\tglobal_load_lds_dwordx4 %1, off\n\ts_mov_b32 m0, %0"
               : "=&s"(keep) : "v"(gsrc), "s"(lds_dst) : "memory");
}
template <int MT, class Epi>
DI void gemm_tile(const u16* __restrict__ X, long ldx, const u16* __restrict__ W, long ldw, int K, char* smem,
                  int m0, int n0, const Epi& epi, bool pre = false, const u16* Xn = nullptr, const u16* Wn = nullptr) {
  const int tid = get_tid(), lane = tid & 63, wave = tid >> 6;
  const int wm = wave & 1, wn = wave >> 1;
  const int lr = lane & 15, g = lane >> 4;
  const int rsw = (lr >> 1) & 7;
  f32x4 acc[4][MT];
  { const float z = zero_f();
#pragma unroll
  for (int a = 0; a < 4; ++a)
#pragma unroll
    for (int b = 0; b < MT; ++b) acc[a][b] = (f32x4){z, z, z, z}; }
  const int wu = __builtin_amdgcn_readfirstlane(wave);
  const unsigned sbase = (unsigned)__builtin_amdgcn_readfirstlane((int)(unsigned)(size_t)smem);
  const int r8 = lane >> 3, c0 = (lane & 7) ^ (r8 >> 1);
  const long oxe = (long)(wu * MT * 8 + r8) * ldx + (c0 << 3), oxo = (long)(wu * MT * 8 + r8) * ldx + ((c0 ^ 4) << 3);
  const long owe = (long)(wu * 32 + r8) * ldw + (c0 << 3), owo = (long)(wu * 32 + r8) * ldw + ((c0 ^ 4) << 3);
  const u16 *xe = X + oxe, *xo = X + oxo, *we = W + owe, *wo = W + owo;
  const long ldx8 = 8 * ldx, ldw8 = 8 * ldw;
  const unsigned xdst = sbase + wu * MT * 1024, wdst = sbase + 16384 + wu * 4096;
#define GT_DMA(BUFOFF)                                                                                          \
  {                                                                                                            \
    _Pragma("unroll") for (int i = 0; i < MT; ++i) dma16(((i & 1) ? xo : xe) + i * ldx8, xdst + (BUFOFF) + i * 1024); \
    _Pragma("unroll") for (int i = 0; i < 4; ++i) dma16(((i & 1) ? wo : we) + i * ldw8, wdst + (BUFOFF) + i * 1024);  \
    xe += 64; xo += 64; we += 64; wo += 64;                                                                    \
  }
  if (!pre) {
    __syncthreads();
    GT_DMA(0u)
  } else {
    xe += 64; xo += 64; we += 64; wo += 64;
  }
  const int nk = K >> 6;
  int kt = 0;
  do {
    asm volatile("s_waitcnt vmcnt(0)" ::: "memory");
    __syncthreads();
    if (kt + 1 < nk) GT_DMA((unsigned)((kt + 1) & 1) * 32768u)
    else if (Xn != nullptr) { xe = Xn + oxe; xo = Xn + oxo; we = Wn + owe; wo = Wn + owo; GT_DMA(0u) }
    const char* cur = smem + (kt & 1) * 32768;
#pragma unroll
    for (int ks = 0; ks < 2; ++ks) {
      bf16x8 xf[MT], wf[4];
      const int ch = ((ks * 4 + g) ^ rsw) << 4;
#pragma unroll
      for (int i = 0; i < MT; ++i) xf[i] = *(const bf16x8*)(cur + (wm * 16 * MT + i * 16 + lr) * 128 + ch);
#pragma unroll
      for (int i = 0; i < 4; ++i) wf[i] = *(const bf16x8*)(cur + 16384 + (wn * 64 + i * 16 + lr) * 128 + ch);
      __builtin_amdgcn_s_setprio(1);
#pragma unroll
      for (int nt = 0; nt < 4; ++nt)
#pragma unroll
        for (int mt = 0; mt < MT; ++mt)
          acc[nt][mt] = __builtin_amdgcn_mfma_f32_16x16x32_bf16(wf[nt], xf[mt], acc[nt][mt], 0, 0, 0);
      __builtin_amdgcn_s_setprio(0);
    }
  } while (++kt < nk);
#undef GT_DMA
  epi.run(acc, m0 + wm * 16 * MT + lr, n0 + wn * 64 + 4 * g);
}

template <int N> DI void wait_vm() { asm volatile("s_waitcnt vmcnt(%0)" ::"n"(N) : "memory"); }

template <int BM, class Epi>
DI void gemm_dma(const u16* __restrict__ X, long ldx, const u16* __restrict__ W, long ldw, int K, char* smem,
                 int m0, int n0, const Epi& epi) {
  constexpr bool BIG = (BM == 256);
  constexpr int D = BIG ? 3 : 4;
  constexpr int STG = BM * 64 + 8192;
  constexpr int MT = BIG ? 4 : BM / 32;
  constexpr int NT = BIG ? 8 : 4;
  constexpr int XD = BM / 64;
  constexpr int PW = XD + 2;
  const int tid = get_tid(), lane = tid & 63, wave = tid >> 6;
  const int lr = lane & 15, g = lane >> 4;
  const int rd = lr * 64 + ((g ^ ((4 - (lr >> 2)) & 3)) << 4);
  const int xrow0 = BIG ? wave * 64 : (wave & 1) * (BM / 2);
  const int wrow0 = BIG ? 0 : (wave >> 1) * 64;
  f32x4 acc[NT][MT];
  { const float z = zero_f();
#pragma unroll
  for (int a = 0; a < NT; ++a)
#pragma unroll
    for (int b = 0; b < MT; ++b) acc[a][b] = (f32x4){z, z, z, z}; }
  const int wu = __builtin_amdgcn_readfirstlane(wave);
  const unsigned sbase = (unsigned)__builtin_amdgcn_readfirstlane((int)(unsigned)(size_t)smem);
  const int r16 = lane >> 2, chunk = (lane & 3) ^ ((4 - (r16 >> 2)) & 3);
  const u16* xs = X + (long)(wu * XD * 16 + r16) * ldx + (chunk << 3);
  const u16* ws = W + (long)(wu * 32 + r16) * ldw + (chunk << 3);
  const long ldx16 = 16 * ldx, ldw16 = 16 * ldw;
  const unsigned xdst = sbase + wu * XD * 1024, wdst = sbase + BM * 64 + wu * 2048;
#define GD_ISSUE(BUF)                                                                                           \
  {                                                                                                            \
    _Pragma("unroll") for (int i = 0; i < XD; ++i) dma16(xs + i * ldx16, xdst + (unsigned)(BUF) * STG + i * 1024); \
    _Pragma("unroll") for (int i = 0; i < 2; ++i) dma16(ws + i * ldw16, wdst + (unsigned)(BUF) * STG + i * 1024);  \
    xs += 32; ws += 32;                                                                                        \
  }
  const int nk = K >> 5;
  __syncthreads();
#pragma unroll
  for (int s = 0; s < D - 1; ++s) GD_ISSUE(s)
  int cur = 0, nxt = D - 1, kt = 0;
  do {
    if (kt + D - 2 < nk) wait_vm<PW * (D - 2)>(); else wait_vm<0>();
    __syncthreads();
    if (kt + D - 1 < nk) GD_ISSUE(nxt)
    nxt = (nxt + 1 == D) ? 0 : nxt + 1;
    const char* base = smem + cur * STG;
    cur = (cur + 1 == D) ? 0 : cur + 1;
    bf16x8 xf[MT];
#pragma unroll
    for (int i = 0; i < MT; ++i) xf[i] = *(const bf16x8*)(base + (xrow0 + i * 16) * 64 + rd);
#pragma unroll
    for (int nh = 0; nh < NT / 4; ++nh) {
      bf16x8 wf[4];
#pragma unroll
      for (int i = 0; i < 4; ++i) wf[i] = *(const bf16x8*)(base + BM * 64 + (wrow0 + (nh * 4 + i) * 16) * 64 + rd);
      __builtin_amdgcn_s_setprio(1);
#pragma unroll
      for (int i = 0; i < 4; ++i)
#pragma unroll
        for (int mt = 0; mt < MT; ++mt)
          acc[nh * 4 + i][mt] = __builtin_amdgcn_mfma_f32_16x16x32_bf16(wf[i], xf[mt], acc[nh * 4 + i][mt], 0, 0, 0);
      __builtin_amdgcn_s_setprio(0);
    }
  } while (++kt < nk);
#undef GD_ISSUE
  epi.run(acc, m0 + xrow0 + lr, n0 + wrow0 + 4 * g);
}

template <class Epi>
DI void gemm_big(const u16* __restrict__ X, long ldx, const u16* __restrict__ W, long ldw, int K, char* smem,
                 int m0, int n0, const Epi& epi) {
  const int tid = get_tid(), lane = tid & 63, wave = tid >> 6;
  const int lr = lane & 15, g = lane >> 4;
  const int rsw = (lr >> 1) & 7;
  const int rd0 = lr * 128 + (((2 * g) ^ rsw) << 4), rd1 = lr * 128 + (((2 * g + 1) ^ rsw) << 4);
  f32x4 acc[8][4];
  { const float z = zero_f();
#pragma unroll
  for (int a = 0; a < 8; ++a)
#pragma unroll
    for (int b = 0; b < 4; ++b) acc[a][b] = (f32x4){z, z, z, z}; }
  const u16* xp = X + (long)(wave * 64 + lr) * ldx + 16 * g;
  const long ldx16 = 16 * ldx;
  const int wrow = wave * 8 + (lane >> 3);
  const u16* wp = W + (long)wrow * ldw + (((lane & 7) ^ ((wrow >> 1) & 7)) << 3);
  const long ldw32 = 32 * ldw;
  const int wdst = tid * 16;
  bf16x8 xa[4], xb[4];
  __syncthreads();
#pragma unroll
  for (int i = 0; i < 4; ++i)
    __builtin_amdgcn_global_load_lds((const unsigned*)(wp + i * ldw32), (unsigned*)(smem + wdst + i * 4096), 16, 0, 0);
#pragma unroll
  for (int mt = 0; mt < 4; ++mt) { xa[mt] = *(const bf16x8*)(xp + mt * ldx16); xb[mt] = *(const bf16x8*)(xp + mt * ldx16 + 8); }
  __syncthreads();
  const int nk = K >> 6;
  int kt = 0;
  do {
    const char* cur = smem + (kt & 1) * 16384;
    char* nxt = smem + ((kt & 1) ^ 1) * 16384;
    const int adv = (kt + 1 < nk) ? 64 : 0;
    xp += adv; wp += adv;
#pragma unroll
    for (int i = 0; i < 4; ++i)
      __builtin_amdgcn_global_load_lds((const unsigned*)(wp + i * ldw32), (unsigned*)(nxt + wdst + i * 4096), 16, 0, 0);
#pragma unroll
    for (int nh = 0; nh < 2; ++nh) {
      bf16x8 wf[4];
#pragma unroll
      for (int i = 0; i < 4; ++i) wf[i] = *(const bf16x8*)(cur + rd0 + (nh * 4 + i) * 2048);
#pragma unroll
      for (int i = 0; i < 4; ++i)
#pragma unroll
        for (int mt = 0; mt < 4; ++mt)
          acc[nh * 4 + i][mt] = __builtin_amdgcn_mfma_f32_16x16x32_bf16(wf[i], xa[mt], acc[nh * 4 + i][mt], 0, 0, 0);
    }
#pragma unroll
    for (int mt = 0; mt < 4; ++mt) xa[mt] = *(const bf16x8*)(xp + mt * ldx16);
#pragma unroll
    for (int nh = 0; nh < 2; ++nh) {
      bf16x8 wf[4];
#pragma unroll
      for (int i = 0; i < 4; ++i) wf[i] = *(const bf16x8*)(cur + rd1 + (nh * 4 + i) * 2048);
#pragma unroll
      for (int i = 0; i < 4; ++i)
#pragma unroll
        for (int mt = 0; mt < 4; ++mt)
          acc[nh * 4 + i][mt] = __builtin_amdgcn_mfma_f32_16x16x32_bf16(wf[i], xb[mt], acc[nh * 4 + i][mt], 0, 0, 0);
    }
#pragma unroll
    for (int mt = 0; mt < 4; ++mt) xb[mt] = *(const bf16x8*)(xp + mt * ldx16 + 8);
    __syncthreads();
  } while (++kt < nk);
  epi.run(acc, m0 + wave * 64 + lr, n0 + 4 * g);
}

DI void st_bf4(u16* p, float a, float b, float c, float d) { *(uint2*)p = make_uint2(pk2(a, b), pk2(c, d)); }

struct EpiE1 {
  u16 *abuf, *uvbuf, *gatebuf; float *spp, *sps;
  template <int NT, int MT> DI void run(f32x4 (&acc)[NT][MT], int mb, int nb) const {
#pragma unroll
    for (int nt = 0; nt < NT; ++nt) {
      const int n = nb + nt * 16;
#pragma unroll
      for (int mt = 0; mt < MT; ++mt) {
        const int m = mb + mt * 16;
        f32x4 v = acc[nt][mt];
        if (n < 1024) {
          st_bf4(abuf + (size_t)m * 1024 + n, v[0], v[1], v[2], v[3]);
          float* dst = nullptr;
          if (m < M_PROMPT) { int t = m & 8191; if (t >= 8177) dst = spp + ((size_t)((m >> 13) * 15 + (t - 8177))) * 1024 + n; }
          else { int r = m - M_PROMPT; int s = r & 31; if (s >= 17) dst = sps + ((size_t)((r >> 5) * 15 + (s - 17))) * 1024 + n; }
          if (dst) *(float4*)dst = make_float4(v[0], v[1], v[2], v[3]);
        } else if (n < 3072) {
          st_bf4(uvbuf + (size_t)m * 2048 + (n - 1024), gelu_f(v[0]), gelu_f(v[1]), gelu_f(v[2]), gelu_f(v[3]));
        } else {
          st_bf4(gatebuf + (size_t)m * 2048 + (n - 3072), silu_f(v[0]), silu_f(v[1]), silu_f(v[2]), silu_f(v[3]));
        }
        __builtin_amdgcn_sched_barrier(0);
      }
    }
  }
};

struct EpiPool {
  const float* scale; u16* mix; int g;
  template <int NT, int MT> DI void run(f32x4 (&acc)[NT][MT], int mb, int nb) const {
#pragma unroll
    for (int nt = 0; nt < NT; ++nt) {
      const int ch = g * 256 + nb + nt * 16;
      const float4 sc = *(const float4*)(scale + ch);
#pragma unroll
      for (int mt = 0; mt < MT; ++mt) {
        const int m = mb + mt * 16;
        u16* q = mix + (size_t)m * 2048 + ch;
        const uint2 gt = *(const uint2*)q;
        f32x4 v = acc[nt][mt];
        st_bf4(q, v[0] * sc.x * bflo(gt.x), v[1] * sc.y * bfhi(gt.x), v[2] * sc.z * bflo(gt.y), v[3] * sc.w * bfhi(gt.y));
      }
    }
  }
};

struct EpiSgu {
  const float* bs; const u16* uv; u16* mix; int g, rowbase, nvalid;
  template <int NT, int MT> DI void run(f32x4 (&acc)[NT][MT], int mb, int nb) const {
#pragma unroll
    for (int mt = 0; mt < MT; ++mt) {
      const int i = mb + mt * 16;
      if (i < nvalid) {
        const float bias = bs[i];
        const size_t row = (size_t)(rowbase + i);
#pragma unroll
        for (int nt = 0; nt < NT; ++nt) {
          const int ch = g * 256 + nb + nt * 16;
          const uint2 uu = *(const uint2*)(uv + row * 2048 + ch);
          u16* q = mix + row * 2048 + 1024 + ch;
          const uint2 gt = *(const uint2*)q;
          f32x4 v = acc[nt][mt];
          st_bf4(q, (v[0] + bias) * bflo(uu.x) * bflo(gt.x), (v[1] + bias) * bfhi(uu.x) * bfhi(gt.x),
                 (v[2] + bias) * bflo(uu.y) * bflo(gt.y), (v[3] + bias) * bfhi(uu.y) * bfhi(gt.y));
        }
      }
    }
  }
};

struct EpiF32 {
  float* C; long ldc;
  template <int NT, int MT> DI void run(f32x4 (&acc)[NT][MT], int mb, int nb) const {
#pragma unroll
    for (int nt = 0; nt < NT; ++nt)
#pragma unroll
      for (int mt = 0; mt < MT; ++mt) {
        f32x4 v = acc[nt][mt];
        *(float4*)(C + (size_t)(mb + mt * 16) * ldc + nb + nt * 16) = make_float4(v[0], v[1], v[2], v[3]);
      }
  }
};

struct EpiBF16 {
  u16* C; long ldc;
  template <int NT, int MT> DI void run(f32x4 (&acc)[NT][MT], int mb, int nb) const {
#pragma unroll
    for (int nt = 0; nt < NT; ++nt)
#pragma unroll
      for (int mt = 0; mt < MT; ++mt) {
        f32x4 v = acc[nt][mt];
        st_bf4(C + (size_t)(mb + mt * 16) * ldc + nb + nt * 16, v[0], v[1], v[2], v[3]);
      }
  }
};

struct EpiVT {
  u16* C; long ldc;
  template <int NT, int MT> DI void run(f32x4 (&acc)[NT][MT], int mb, int nb) const {
#pragma unroll
    for (int nt = 0; nt < NT; ++nt) {
      const int n = nb + nt * 16;
      const int np = (n & ~12) | ((n & 4) << 1) | ((n & 8) >> 1);
#pragma unroll
      for (int mt = 0; mt < MT; ++mt) {
        f32x4 v = acc[nt][mt];
        st_bf4(C + (size_t)(mb + mt * 16) * ldc + np, v[0], v[1], v[2], v[3]);
      }
    }
  }
};

struct EpiO1 {
  float* zq; u16* gate;
  template <int NT, int MT> DI void run(f32x4 (&acc)[NT][MT], int mb, int nb) const {
#pragma unroll
    for (int nt = 0; nt < NT; ++nt) {
      const int n = nb + nt * 16;
#pragma unroll
      for (int mt = 0; mt < MT; ++mt) {
        const int m = mb + mt * 16;
        f32x4 v = acc[nt][mt];
        if (n < 704) *(float4*)(zq + (size_t)m * 704 + n) = make_float4(v[0], v[1], v[2], v[3]);
        else if (n < 1728) st_bf4(gate + (size_t)m * 1024 + (n - 704), silu_f(v[0]), silu_f(v[1]), silu_f(v[2]), silu_f(v[3]));
        __builtin_amdgcn_sched_barrier(0);
      }
    }
  }
};

struct EpiQup {
  const float2* rope; u16* q;
  template <int NT, int MT> DI void run(f32x4 (&acc)[NT][MT], int mb, int nb) const {
    const int g4 = nb & 15;
#pragma unroll
    for (int q4 = 0; q4 < NT / 4; ++q4) {
      const int grp = ((nb - g4) >> 6) + q4;
      if ((grp % 3) == 2) {
#pragma unroll
        for (int mt = 0; mt < MT; ++mt) {
          const int pos = tok_pos(mb + mt * 16);
#pragma unroll
          for (int nt = 0; nt < 2; ++nt)
#pragma unroll
            for (int j = 0; j < 4; ++j) {
              const float2 cs = rope[pos * 32 + nt * 16 + g4 + j];
              const float x1 = acc[q4 * 4 + nt][mt][j], x2 = acc[q4 * 4 + nt + 2][mt][j];
              acc[q4 * 4 + nt][mt][j] = x1 * cs.x - x2 * cs.y;
              acc[q4 * 4 + nt + 2][mt][j] = x2 * cs.x + x1 * cs.y;
            }
        }
      }
    }
#pragma unroll
    for (int nt = 0; nt < NT; ++nt)
#pragma unroll
      for (int mt = 0; mt < MT; ++mt) {
        f32x4 v = acc[nt][mt];
        st_bf4(q + (size_t)(mb + mt * 16) * 1536 + nb + nt * 16, v[0] * QSCALE, v[1] * QSCALE, v[2] * QSCALE, v[3] * QSCALE);
      }
  }
};

DI void tconv_tile(const float* __restrict__ src, long lds, int cvalid, u16* __restrict__ dst, long ldd, int r0, int c0, char* smem) {
  float (*T)[65] = (float (*)[65])smem;
  const int tid = get_tid();
  __syncthreads();
  const int lr = tid >> 4, lc = (tid & 15) * 4;
#pragma unroll
  for (int i = 0; i < 4; ++i) {
    const int r = lr + 16 * i;
    float4 v = make_float4(0.f, 0.f, 0.f, 0.f);
    if (c0 + lc < cvalid) v = *(const float4*)(src + (long)(r0 + r) * lds + c0 + lc);
    T[r][lc] = v.x; T[r][lc + 1] = v.y; T[r][lc + 2] = v.z; T[r][lc + 3] = v.w;
  }
  __syncthreads();
  const int oc = tid >> 2, seg = (tid & 3) * 16;
  unsigned pk[8];
#pragma unroll
  for (int k = 0; k < 8; ++k) pk[k] = pk2(T[seg + 2 * k][oc], T[seg + 2 * k + 1][oc]);
  uint4* d = (uint4*)(dst + (long)(c0 + oc) * ldd + r0 + seg);
  d[0] = make_uint4(pk[0], pk[1], pk[2], pk[3]);
  d[1] = make_uint4(pk[4], pk[5], pk[6], pk[7]);
}

DI void convert_weights(const Params& p, int layer, char* smem) {
  u16* W = (u16*)(p.ws + OFF_W);
  const int tid = get_tid();
  if ((layer & 1) == 0) {
    const int e = layer >> 1;
    for (int t = get_bid(); t < 1920; t += gridDim.x) {
      if (t < 1280) {
        tconv_tile(p.w_in_even + (size_t)e * 1024 * 5120, 5120, 5120, W + WE_IN, 1024, (t / 80) * 64, (t % 80) * 64, smem);
      } else if (t < 1792) {
        const int u = t - 1280;
        tconv_tile(p.w_out_even + (size_t)e * 2048 * 1024, 1024, 1024, W + WE_OUT, 2048, (u >> 4) * 64, (u & 15) * 64, smem);
      } else if (t < 1856) {
        const int u = t - 1792, g = u >> 4, v = u & 15;
        tconv_tile(p.w_pool + (size_t)(e * 4 + g) * 65536, 256, 256, W + WE_POOL + (size_t)g * 65536, 256, (v >> 2) * 64, (v & 3) * 64, smem);
      } else {
        const int idx = (t - 1856) * 1024 + tid * 4;
        const int i = (idx >> 7) & 127, j = idx & 127;
        float4 v = *(const float4*)(p.w_spatial + (size_t)e * 65536 + idx);
        if ((j >> 6) > (i >> 6)) v = make_float4(0.f, 0.f, 0.f, 0.f);
        st_bf4(W + WE_WS + idx, v.x, v.y, v.z, v.w);
      }
    }
  } else {
    const int o = layer >> 1;
    float2* rope = (float2*)(p.ws + OFFB_ROPE);
    for (int t = get_bid(); t < 2000; t += gridDim.x) {
      if (t < 448) {
        tconv_tile(p.w_in_odd + (size_t)o * 1024 * 1728, 1728, 1728, W + WO_IN, 1024, (t / 28) * 64, (t % 28) * 64, smem);
      } else if (t < 592) {
        const int u = t - 448;
        tconv_tile(p.w_q_up + (size_t)o * 384 * 1536, 1536, 1536, W + WO_Q, 384, (u / 24) * 64, (u % 24) * 64, smem);
      } else if (t < 720) {
        const int u = t - 592;
        const int c0 = (u & 31) * 64, hh = c0 >> 8, j0 = c0 & 255;
        const int drow0 = j0 < 128 ? hh * 128 + j0 : 1024 + hh * 128 + (j0 - 128);
        tconv_tile(p.w_kv_up + (size_t)o * 256 * 2048, 2048, 2048, W + WO_KV + (long)(drow0 - c0) * 256, 256, (u >> 5) * 64, c0, smem);
      } else if (t < 976) {
        const int u = t - 720;
        tconv_tile(p.w_o + (size_t)o * 1024 * 1024, 1024, 1024, W + WO_O, 1024, (u >> 4) * 64, (u & 15) * 64, smem);
      } else {
        const int idx = (t - 976) * 256 + tid;
        const int pos = idx >> 5, i = idx & 31;
        const float freq = exp2f(-(float)i * (13.287712379549449f / 32.f));
        const float ang = (float)pos * freq;
        float s, c;
        sincosf(ang, &s, &c);
        rope[idx] = make_float2(c, s);
      }
    }
  }
}

DI void prenorm0(const Params& p) {
  const int lane = get_tid() & 63;
  u16* h = (u16*)(p.ws + OFF_H);
  for (int r = get_bid() * 4 + (get_tid() >> 6); r < M_TOK; r += gridDim.x * 4) {
    const float* x = r < M_PROMPT ? p.x_prompt + (size_t)r * 1024 : p.x_sample + (size_t)(r - M_PROMPT) * 1024;
    float4 v[4]; float ss = 0.f;
#pragma unroll
    for (int i = 0; i < 4; ++i) { v[i] = *(const float4*)(x + lane * 4 + 256 * i); ss += v[i].x * v[i].x + v[i].y * v[i].y + v[i].z * v[i].z + v[i].w * v[i].w; }
    ss = wave_sum(ss);
    const float rs = rsqrtf(ss * (1.f / 1024.f) + 1e-6f);
#pragma unroll
    for (int i = 0; i < 4; ++i) {
      const float4 gg = *(const float4*)(p.norm_pre + lane * 4 + 256 * i);
      st_bf4(h + (size_t)r * 1024 + lane * 4 + 256 * i, v[i].x * rs * gg.x, v[i].y * rs * gg.y, v[i].z * rs * gg.z, v[i].w * rs * gg.w);
    }
  }
}

DI void resid_norm(const Params& p, int layer, const u16* __restrict__ y) {
  const int lane = get_tid() & 63;
  u16* h = (u16*)(p.ws + OFF_H);
  const float* gpost = p.norm_post + layer * 1024;
  const float* gpre = p.norm_pre + (layer + 1) * 1024;
  for (int r = get_bid() * 4 + (get_tid() >> 6); r < M_TOK; r += gridDim.x * 4) {
    const float* x;
    if (layer == 0) x = r < M_PROMPT ? p.x_prompt + (size_t)r * 1024 : p.x_sample + (size_t)(r - M_PROMPT) * 1024;
    else x = p.out + (size_t)r * 1024;
    float4 yv[4], xv[4]; float ss = 0.f;
#pragma unroll
    for (int i = 0; i < 4; ++i) {
      { const uint2 yq = *(const uint2*)(y + (size_t)r * 1024 + lane * 4 + 256 * i); yv[i] = make_float4(bflo(yq.x), bfhi(yq.x), bflo(yq.y), bfhi(yq.y)); }
      xv[i] = *(const float4*)(x + lane * 4 + 256 * i);
      ss += yv[i].x * yv[i].x + yv[i].y * yv[i].y + yv[i].z * yv[i].z + yv[i].w * yv[i].w;
    }
    ss = wave_sum(ss);
    const float rs = rsqrtf(ss * (1.f / 1024.f) + 1e-6f);
    float ss2 = 0.f;
#pragma unroll
    for (int i = 0; i < 4; ++i) {
      const float4 gg = *(const float4*)(gpost + lane * 4 + 256 * i);
      xv[i].x += yv[i].x * rs * gg.x; xv[i].y += yv[i].y * rs * gg.y; xv[i].z += yv[i].z * rs * gg.z; xv[i].w += yv[i].w * rs * gg.w;
      *(float4*)(p.out + (size_t)r * 1024 + lane * 4 + 256 * i) = xv[i];
      ss2 += xv[i].x * xv[i].x + xv[i].y * xv[i].y + xv[i].z * xv[i].z + xv[i].w * xv[i].w;
    }
    if (layer < 3) {
      ss2 = wave_sum(ss2);
      const float rs2 = rsqrtf(ss2 * (1.f / 1024.f) + 1e-6f);
#pragma unroll
      for (int i = 0; i < 4; ++i) {
        const float4 gg = *(const float4*)(gpre + lane * 4 + 256 * i);
        st_bf4(h + (size_t)r * 1024 + lane * 4 + 256 * i, xv[i].x * rs2 * gg.x, xv[i].y * rs2 * gg.y, xv[i].z * rs2 * gg.z, xv[i].w * rs2 * gg.w);
      }
    }
  }
}

DI void sgu_ln_items(const Params& p, int e, char* smem) {
  const int tid = get_tid(), lane = tid & 63, wave = tid >> 6;
  const u16* uv = (const u16*)(p.ws + OFF_UV);
  u16* vT = (u16*)(p.ws + OFF_VTE);
  float2* st = (float2*)smem;
  u16* T = (u16*)(smem + 1024);
  const float* lg = p.sgu_ln_g + e * 1024;
  const float* lb = p.sgu_ln_b + e * 1024;
  for (int it = get_bid(); it < 576; it += gridDim.x) {
    const int c = it >> 2, gq = it & 3;
    const int rowbase = c < 128 ? c * 128 : M_PROMPT + (c - 128) * 32;
    const int nvalid = c < 128 ? 128 : 32;
    __syncthreads();
#pragma unroll 1
    for (int b8 = 0; b8 < 32; b8 += 8) {
      u32x4 q[8][2];
#pragma unroll
      for (int k = 0; k < 8; ++k) {
        const int i = wave * 32 + b8 + k;
        const int ic = i < nvalid ? i : 0;
        const u16* src = uv + (size_t)(rowbase + ic) * 2048 + 1024 + lane * 8;
        q[k][0] = *(const u32x4*)src;
        q[k][1] = *(const u32x4*)(src + 512);
      }
#pragma unroll
      for (int k = 0; k < 8; ++k) {
        const int i = wave * 32 + b8 + k;
        float s = 0.f, s2 = 0.f;
#pragma unroll
        for (int j = 0; j < 2; ++j)
#pragma unroll
          for (int w4 = 0; w4 < 4; ++w4) {
            const float lo = bflo(q[k][j][w4]), hi = bfhi(q[k][j][w4]);
            s += lo + hi; s2 += lo * lo + hi * hi;
          }
        s = wave_sum(s); s2 = wave_sum(s2);
        const float mu = s * (1.f / 1024.f);
        const float var = fmaxf(s2 * (1.f / 1024.f) - mu * mu, 0.f);
        const float rstd = rsqrtf(var + 1e-6f);
        if (lane == 0) st[i] = i < nvalid ? make_float2(mu, rstd) : make_float2(0.f, 0.f);
      }
    }
    __syncthreads();
    const int rr = tid >> 3, cc = tid & 7;
    u32x4 ld[4][4];
#pragma unroll
    for (int sl = 0; sl < 4; ++sl)
#pragma unroll
      for (int i4 = 0; i4 < 4; ++i4) {
        const int i = rr + 32 * i4;
        const int ic = i < nvalid ? i : 0;
        ld[sl][i4] = *(const u32x4*)(uv + (size_t)(rowbase + ic) * 2048 + 1024 + gq * 256 + sl * 64 + cc * 8);
      }
#pragma unroll
    for (int sl = 0; sl < 4; ++sl) {
      const int ch = gq * 256 + sl * 64 + cc * 8;
      const float4 g0 = *(const float4*)(lg + ch), g1 = *(const float4*)(lg + ch + 4);
      const float4 b0 = *(const float4*)(lb + ch), b1 = *(const float4*)(lb + ch + 4);
#pragma unroll
      for (int i4 = 0; i4 < 4; ++i4) {
        const int i = rr + 32 * i4;
        float o[8];
        if (i < nvalid) {
          const u32x4 q = ld[sl][i4];
          const float2 ms = st[i];
          o[0] = (bflo(q[0]) - ms.x) * ms.y * g0.x + b0.x; o[1] = (bfhi(q[0]) - ms.x) * ms.y * g0.y + b0.y;
          o[2] = (bflo(q[1]) - ms.x) * ms.y * g0.z + b0.z; o[3] = (bfhi(q[1]) - ms.x) * ms.y * g0.w + b0.w;
          o[4] = (bflo(q[2]) - ms.x) * ms.y * g1.x + b1.x; o[5] = (bfhi(q[2]) - ms.x) * ms.y * g1.y + b1.y;
          o[6] = (bflo(q[3]) - ms.x) * ms.y * g1.z + b1.z; o[7] = (bfhi(q[3]) - ms.x) * ms.y * g1.w + b1.w;
          if (c >= 128) {
            float* dst = p.out + OUT_SGUV + ((size_t)(e * 16 + (c - 128)) * 32 + i) * 1024 + ch;
            *(float4*)dst = make_float4(o[0], o[1], o[2], o[3]);
            *(float4*)(dst + 4) = make_float4(o[4], o[5], o[6], o[7]);
          }
        } else {
#pragma unroll
          for (int k = 0; k < 8; ++k) o[k] = 0.f;
        }
#pragma unroll
        for (int k = 0; k < 8; ++k) T[(cc * 8 + k) * 136 + i] = f2bf(o[k]);
      }
      __syncthreads();
#pragma unroll
      for (int j = 0; j < 4; ++j) {
        const int idx = tid + 256 * j;
        const int chl = idx >> 4, pc = idx & 15;
        const uint4 q = *(const uint4*)(T + chl * 136 + pc * 8);
        *(uint4*)(vT + ((size_t)c * 1024 + gq * 256 + sl * 64 + chl) * 128 + pc * 8) = q;
      }
      __syncthreads();
    }
  }
}

template <int W>
DI void pool_d_one(const u16* __restrict__ a, u16* __restrict__ d, const float* __restrict__ hist, int r, int ch0) {
  float acc[8];
#pragma unroll
  for (int k = 0; k < 8; ++k) acc[k] = 0.f;
  u32x4 q[W];
  float cnt;
  if (r < M_PROMPT) {
    const int t = r & 8191;
#pragma unroll
    for (int i = 0; i < W; ++i) q[i] = *(const u32x4*)(a + (size_t)(r - (i < t ? i : t)) * 1024 + ch0);
#pragma unroll
    for (int i = 0; i < W; ++i) {
      const float m = i <= t ? 1.f : 0.f;
      acc[0] += m * bflo(q[i][0]); acc[1] += m * bfhi(q[i][0]); acc[2] += m * bflo(q[i][1]); acc[3] += m * bfhi(q[i][1]);
      acc[4] += m * bflo(q[i][2]); acc[5] += m * bfhi(q[i][2]); acc[6] += m * bflo(q[i][3]); acc[7] += m * bfhi(q[i][3]);
    }
    cnt = (float)(t + 1 < W ? t + 1 : W);
  } else {
    const int rr = r - M_PROMPT, b = rr >> 5, s = rr & 31;
    f32x4 h[W][2];
#pragma unroll
    for (int i = 0; i < W; ++i) {
      q[i] = *(const u32x4*)(a + (size_t)(r - (i < s ? i : s)) * 1024 + ch0);
      const int hi = 15 + s - i;
      const float* hp = hist + ((size_t)b * 15 + (hi < 0 ? 0 : (hi > 14 ? 14 : hi))) * 1024 + ch0;
      h[i][0] = *(const f32x4*)hp; h[i][1] = *(const f32x4*)(hp + 4);
    }
#pragma unroll
    for (int i = 0; i < W; ++i) {
      const float m = i <= s ? 1.f : 0.f, mh = 1.f - m;
      acc[0] += m * bflo(q[i][0]) + mh * h[i][0][0]; acc[1] += m * bfhi(q[i][0]) + mh * h[i][0][1];
      acc[2] += m * bflo(q[i][1]) + mh * h[i][0][2]; acc[3] += m * bfhi(q[i][1]) + mh * h[i][0][3];
      acc[4] += m * bflo(q[i][2]) + mh * h[i][1][0]; acc[5] += m * bfhi(q[i][2]) + mh * h[i][1][1];
      acc[6] += m * bflo(q[i][3]) + mh * h[i][1][2]; acc[7] += m * bfhi(q[i][3]) + mh * h[i][1][3];
    }
    cnt = (float)W;
  }
  const float inv = 1.f / cnt;
  const u32x4 self = q[0];
  u32x4 o;
  o[0] = pk2(acc[0] * inv - bflo(self[0]), acc[1] * inv - bfhi(self[0]));
  o[1] = pk2(acc[2] * inv - bflo(self[1]), acc[3] * inv - bfhi(self[1]));
  o[2] = pk2(acc[4] * inv - bflo(self[2]), acc[5] * inv - bfhi(self[2]));
  o[3] = pk2(acc[6] * inv - bflo(self[3]), acc[7] * inv - bfhi(self[3]));
  *(u32x4*)(d + (size_t)r * 1024 + ch0) = o;
}

DI void pool_d_items(const Params& p, int e) {
  const u16* a = (const u16*)(p.ws + OFF_A);
  u16* d = (u16*)(p.ws + OFF_H);
  const float* hist = p.cache_pool + (size_t)e * 16 * 15 * 1024;
  const int tid = get_tid(), lane = tid & 63;
  for (int wi = get_bid() * 4 + (tid >> 6); wi < (M_TOK / 2) * 4; wi += gridDim.x * 4) {
    const int g = __builtin_amdgcn_readfirstlane(wi & 3);
    const int r = (wi >> 2) * 2 + (lane >> 5), ch0 = g * 256 + (lane & 31) * 8;
    if (g == 0) pool_d_one<2>(a, d, hist, r, ch0);
    else if (g == 1) pool_d_one<4>(a, d, hist, r, ch0);
    else if (g == 2) pool_d_one<8>(a, d, hist, r, ch0);
    else pool_d_one<16>(a, d, hist, r, ch0);
  }
}

DI void odd_rows(const Params& p, int o) {
  const int tid = get_tid(), lane = tid & 63;
  const float* zq = (const float*)(p.ws + OFF_ZQ);
  u16* qn = (u16*)(p.ws + OFF_QN);
  u16* ckvb = (u16*)(p.ws + OFF_CKVB);
  u16* krb = (u16*)(p.ws + OFFB_KROPEB);
  const float2* rope = (const float2*)(p.ws + OFFB_ROPE);
  const float* qnw = p.q_norm + o * 384;
  const float* kvw = p.kv_norm + o * 256;
  for (int r = get_bid() * 4 + (tid >> 6); r < M_TOK; r += gridDim.x * 4) {
    const float* z = zq + (size_t)r * 704;
    float2 qv[3]; float ss = 0.f;
#pragma unroll
    for (int i = 0; i < 3; ++i) { qv[i] = *(const float2*)(z + lane * 2 + 128 * i); ss += qv[i].x * qv[i].x + qv[i].y * qv[i].y; }
    const float4 kv = *(const float4*)(z + 384 + lane * 4);
    float sk = kv.x * kv.x + kv.y * kv.y + kv.z * kv.z + kv.w * kv.w;
    const float kr = z[640 + lane];
    ss = wave_sum(ss); sk = wave_sum(sk);
    const float rq = rsqrtf(ss * (1.f / 384.f) + 1e-6f);
    const float rk = rsqrtf(sk * (1.f / 256.f) + 1e-6f);
#pragma unroll
    for (int i = 0; i < 3; ++i) {
      const float2 w = *(const float2*)(qnw + lane * 2 + 128 * i);
      *(unsigned*)(qn + (size_t)r * 384 + lane * 2 + 128 * i) = pk2(qv[i].x * rq * w.x, qv[i].y * rq * w.y);
    }
    size_t kvrow; float *dck, *dkr; int pos;
    if (r < M_PROMPT) {
      kvrow = r; pos = r & 8191;
      dck = p.out + OUT_CKVP + ((size_t)o * 16384 + r) * 256;
      dkr = p.out + OUT_KRP + ((size_t)o * 16384 + r) * 64;
    } else {
      const int rr = r - M_PROMPT, b = rr >> 5, s = rr & 31;
      kvrow = (size_t)M_PROMPT + b * KSTR_S + 1024 + s; pos = 1024 + s;
      dck = p.out + OUT_CKVS + ((size_t)o * 512 + rr) * 256;
      dkr = p.out + OUT_KRS + ((size_t)o * 512 + rr) * 64;
    }
    const float4 w4 = *(const float4*)(kvw + lane * 4);
    const float c0 = kv.x * rk * w4.x, c1 = kv.y * rk * w4.y, c2 = kv.z * rk * w4.z, c3 = kv.w * rk * w4.w;
    *(float4*)(dck + lane * 4) = make_float4(c0, c1, c2, c3);
    st_bf4(ckvb + kvrow * 256 + lane * 4, c0, c1, c2, c3);
    const float other = __shfl_xor(kr, 32, 64);
    const float2 cs = rope[pos * 32 + (lane & 31)];
    const float ro = lane < 32 ? kr * cs.x - other * cs.y : kr * cs.x + other * cs.y;
    dkr[lane] = ro;
    krb[kvrow * 64 + lane] = f2bf(ro);
  }
  const int gt = get_bid() * 256 + tid, gs = gridDim.x * 256;
  const float* cck = p.cache_ckv + (size_t)o * 16 * 1024 * 256;
  const float* ckr = p.cache_krope + (size_t)o * 16 * 1024 * 64;
  for (int idx = gt; idx < 524288; idx += gs) {
    const int b = idx >> 15, rem = idx & 32767, k = rem >> 5, c8 = (rem & 31) * 8;
    const float* s = cck + ((size_t)(b * 1024 + k)) * 256 + c8;
    const float4 a0 = *(const float4*)s, a1 = *(const float4*)(s + 4);
    *(uint4*)(ckvb + ((size_t)M_PROMPT + b * KSTR_S + k) * 256 + c8) = make_uint4(pk2(a0.x, a0.y), pk2(a0.z, a0.w), pk2(a1.x, a1.y), pk2(a1.z, a1.w));
  }
  for (int idx = gt; idx < 131072; idx += gs) {
    const int b = idx >> 13, rem = idx & 8191, k = rem >> 3, c8 = (rem & 7) * 8;
    const float* s = ckr + ((size_t)(b * 1024 + k)) * 64 + c8;
    const float4 a0 = *(const float4*)s, a1 = *(const float4*)(s + 4);
    *(uint4*)(krb + ((size_t)M_PROMPT + b * KSTR_S + k) * 64 + c8) = make_uint4(pk2(a0.x, a0.y), pk2(a0.z, a0.w), pk2(a1.x, a1.y), pk2(a1.z, a1.w));
  }
  const unsigned zu = __float_as_uint(zero_f());
  for (int idx = gt; idx < 16 * 96 * 32; idx += gs) {
    const int b = idx / 3072, rem = idx % 3072, k = 1056 + (rem >> 5), c8 = (rem & 31) * 8;
    *(uint4*)(ckvb + ((size_t)M_PROMPT + b * KSTR_S + k) * 256 + c8) = make_uint4(zu, zu, zu, zu);
  }
  for (int idx = gt; idx < 16 * 96 * 8; idx += gs) {
    const int b = idx / 768, rem = idx % 768, k = 1056 + (rem >> 3), c8 = (rem & 7) * 8;
    *(uint4*)(krb + ((size_t)M_PROMPT + b * KSTR_S + k) * 64 + c8) = make_uint4(zu, zu, zu, zu);
  }
}

DI void attn_item(const u16* __restrict__ qbuf, const u16* __restrict__ knope, const u16* __restrict__ krope,
                  const u16* __restrict__ vt, long vt_ld, u16* __restrict__ ao, int head, int qrow0, int nwaves,
                  long kvrow0, int ntiles, int tiles_lo, int nkeys, char* smem, bool dry, bool rev = false) {
  const int tid = get_tid();
  const int lane = tid & 63, wave = tid >> 6;
  const int l31 = lane & 31, h2 = lane >> 5;
  const bool active = wave < nwaves;
  const int my_tiles = wave < 2 ? tiles_lo : ntiles;
  const int qrow = qrow0 + wave * 32 + l31;
  const int rsw = (l31 >> 1) & 7;
  int koff[4];
#pragma unroll
  for (int c4 = 0; c4 < 4; ++c4) koff[c4] = l31 * 128 + (((2 * c4 + h2) ^ rsw) << 4);
  bf16x8 qf[12];
  if (active) {
    const u16* qp = qbuf + (size_t)qrow * 1536 + head * 192 + h2 * 8;
#pragma unroll
    for (int ks = 0; ks < 12; ++ks) qf[ks] = *(const bf16x8*)(qp + ks * 16);
  } else {
#pragma unroll
    for (int ks = 0; ks < 12; ++ks) qf[ks] = (bf16x8){0, 0, 0, 0, 0, 0, 0, 0};
  }
  f32x16 oacc[4];
  { const float z = zero_f();
#pragma unroll
  for (int i = 0; i < 4; ++i)
#pragma unroll
    for (int j = 0; j < 16; ++j) oacc[i][j] = z; }
  float m_run = -INFINITY, l_run = 0.f;

  const int wu = __builtin_amdgcn_readfirstlane(wave);
  const unsigned sbase = (unsigned)__builtin_amdgcn_readfirstlane((int)(unsigned)(size_t)smem);
  const int r8 = lane >> 3, c0 = (lane & 7) ^ (r8 >> 1);
  const unsigned ce = (unsigned)(c0 << 3), co = (unsigned)((c0 ^ 4) << 3);
  unsigned ko = (unsigned)((kvrow0 + (wu & 1) * 32 + r8) * 1024 + head * 128 + (wu >> 1) * 64);
  unsigned ro = (unsigned)((kvrow0 + wu * 16 + r8) * 64);
  unsigned vo = (unsigned)((head * 128 + wu * 32 + r8) * vt_ld);
  const unsigned vld8 = (unsigned)vt_ld * 8u;
  const unsigned kdst = sbase + (wu >> 1) * 8192 + (wu & 1) * 4096;
  const unsigned rdst = sbase + 16384 + wu * 2048;
  const unsigned vdst = sbase + 24576 + wu * 4096;
#define ATT_DMA(BUFOFF)                                                                                        \
  {                                                                                                            \
    _Pragma("unroll") for (int i = 0; i < 4; ++i) dma16(knope + (ko + (unsigned)i * 8192u + ((i & 1) ? co : ce)), kdst + (BUFOFF) + i * 1024); \
    _Pragma("unroll") for (int i = 0; i < 2; ++i) dma16(krope + (ro + (unsigned)i * 512u + ((i & 1) ? co : ce)), rdst + (BUFOFF) + i * 1024);   \
    _Pragma("unroll") for (int i = 0; i < 4; ++i) dma16(vt + (vo + (unsigned)i * vld8 + ((i & 1) ? co : ce)), vdst + (BUFOFF) + i * 1024);      \
    ko += kstep; ro += rstep; vo += vstep;                                                                     \
  }
  const unsigned kstep = rev ? 0u - 65536u : 65536u, rstep = rev ? 0u - 4096u : 4096u, vstep = rev ? 0u - 64u : 64u;
  if (rev) { ko += (unsigned)(ntiles - 1) * 65536u; ro += (unsigned)(ntiles - 1) * 4096u; vo += (unsigned)(ntiles - 1) * 64u; }
  __syncthreads();
  ATT_DMA(0u)
  for (int kt = 0; kt < ntiles; ++kt) {
    asm volatile("s_waitcnt vmcnt(0)" ::: "memory");
    __syncthreads();
    if (kt + 1 < ntiles) ATT_DMA((unsigned)((kt + 1) & 1) * 40960u)
    const int tix = rev ? ntiles - 1 - kt : kt;
    if (active && tix < my_tiles) {
      const char* cur = smem + (kt & 1) * 40960;
      f32x16 st[2];
      __builtin_amdgcn_s_setprio(1);
#pragma unroll
      for (int mt = 0; mt < 2; ++mt) {
#pragma unroll
        for (int j = 0; j < 16; ++j) st[mt][j] = 0.f;
#pragma unroll
        for (int ks = 0; ks < 12; ++ks) {
          const bf16x8 kf = *(const bf16x8*)(cur + koff[ks & 3] + (ks >> 2) * 8192 + mt * 4096);
          st[mt] = __builtin_amdgcn_mfma_f32_32x32x16_bf16(kf, qf[ks], st[mt], 0, 0, 0);
        }
      }
      __builtin_amdgcn_s_setprio(0);
      if (tix * 64 + 64 > nkeys) {
#pragma unroll
        for (int mt = 0; mt < 2; ++mt)
#pragma unroll
          for (int j = 0; j < 16; ++j) {
            const int key = tix * 64 + mt * 32 + (j & 3) + 8 * (j >> 2) + 4 * h2;
            if (key >= nkeys) st[mt][j] = -INFINITY;
          }
      }
      float mx = fmaxf(st[0][0], st[1][0]);
#pragma unroll
      for (int j = 1; j < 16; ++j) mx = fmaxf(mx, fmaxf(st[0][j], st[1][j]));
      mx = fmaxf(mx, __shfl_xor(mx, 32, 64));
      const float m_new = fmaxf(m_run, mx);
      const float alpha = __builtin_amdgcn_exp2f(m_run - m_new);
      m_run = m_new;
      float ps = 0.f;
#pragma unroll
      for (int mt = 0; mt < 2; ++mt)
#pragma unroll
        for (int j = 0; j < 16; ++j) { const float pv = __builtin_amdgcn_exp2f(st[mt][j] - m_new); st[mt][j] = pv; ps += pv; }
      l_run = l_run * alpha + ps;
      if (__any(alpha != 1.f)) {
#pragma unroll
        for (int i = 0; i < 4; ++i)
#pragma unroll
          for (int j = 0; j < 16; ++j) oacc[i][j] *= alpha;
      }
#pragma unroll
      for (int mt = 0; mt < 2; ++mt)
#pragma unroll
        for (int s = 0; s < 2; ++s) {
          union { bf16x8 v; unsigned u[4]; } pf;
#pragma unroll
          for (int k = 0; k < 4; ++k) pf.u[k] = pk2(st[mt][8 * s + 2 * k], st[mt][8 * s + 2 * k + 1]);
          __builtin_amdgcn_s_setprio(1);
#pragma unroll
          for (int vt4 = 0; vt4 < 4; ++vt4) {
            const bf16x8 vf = *(const bf16x8*)(cur + 24576 + koff[mt * 2 + s] + vt4 * 4096);
            oacc[vt4] = __builtin_amdgcn_mfma_f32_32x32x16_bf16(vf, pf.v, oacc[vt4], 0, 0, 0);
          }
          __builtin_amdgcn_s_setprio(0);
        }
    }
  }
#undef ATT_DMA
  const float lt_probe = l_run + oacc[0][0] + oacc[1][5] + oacc[2][9] + oacc[3][15];
  if (active && (!dry || lt_probe == 123456.789f)) {
    const float lt = l_run + __shfl_xor(l_run, 32, 64);
    const float inv = 1.f / lt;
    u16* op = ao + (size_t)qrow * 1024 + head * 128 + 4 * h2;
#pragma unroll
    for (int vt4 = 0; vt4 < 4; ++vt4)
#pragma unroll
      for (int a = 0; a < 4; ++a) {
        u16* q = op + vt4 * 32 + 8 * a;
        const uint2 gt = *(const uint2*)q;
        st_bf4(q, oacc[vt4][4 * a] * inv * bflo(gt.x), oacc[vt4][4 * a + 1] * inv * bfhi(gt.x),
               oacc[vt4][4 * a + 2] * inv * bflo(gt.y), oacc[vt4][4 * a + 3] * inv * bfhi(gt.y));
      }
  }
}

DI void attn_phase(const Params& p, char* smem, bool dry) {
  const u16* qbuf = (const u16*)(p.ws + OFF_ZQ);
  const u16* knope = (const u16*)(p.ws + OFF_KN);
  const u16* krb = (const u16*)(p.ws + OFFB_KROPEB);
  const u16* vtb = (const u16*)(p.ws + OFF_VTO);
  u16* ao = (u16*)(p.ws + OFF_GO);
  for (int it = get_bid(); it < 640; it += gridDim.x) {
    if (it < 512) {
      const int bh = (it & 7) * 2 + ((it >> 3) & 1), qp = it >> 4;
      const int b = bh >> 3, h = bh & 7;
      const u16* vt = vtb + (size_t)b * 1024 * 8192;
#pragma unroll 1
      for (int half = 0; half < 2; ++half) {
        const int qb = half == 0 ? 63 - qp : qp;
        attn_item(qbuf, knope, krb, vt, 8192, ao, h, b * 8192 + qb * 128, 4, (long)b * 8192, 2 * qb + 2, 2 * qb + 1,
                  (2 * qb + 2) * 64, smem, dry, half == 1);
      }
    } else {
      const int s = it - 512, b = s >> 3, h = s & 7;
      const u16* vt = vtb + (size_t)2 * 1024 * 8192 + (size_t)b * 1024 * KSTR_S;
      attn_item(qbuf, knope, krb, vt, KSTR_S, ao, h, M_PROMPT + b * 32, 1, (long)M_PROMPT + (long)b * KSTR_S, 17, 17, 1056, smem, dry);
    }
  }
  __syncthreads();
  if (get_tid() == 0) { const unsigned zu = __float_as_uint(zero_f()); *(uint4*)(smem + 81904) = make_uint4(zu, zu, zu, zu); }
}

#define XB_TMO      128
#define XB_XCNT(j)  (256  + 64 * (j))
#define XB_XSUB(j)  (1280 + 64 * (j))
#define XB_XGEN(j)  (2304 + 64 * (j))
#define XB_TOP      3328
#define XB_TOPGEN   3392
#define XCD_BAR_WORDS 3456
#define XB_SPIN_CAP (1u << 20)
#define LAS __attribute__((address_space(3)))
constexpr size_t OFFB_BAR = 16000000;

DI unsigned xb_ld(unsigned* p) { return __hip_atomic_load(p, __ATOMIC_RELAXED, __HIP_MEMORY_SCOPE_AGENT); }
DI unsigned xb_add(unsigned* p, unsigned v) { return __hip_atomic_fetch_add(p, v, __ATOMIC_RELAXED, __HIP_MEMORY_SCOPE_AGENT); }
DI unsigned xb_xcc_id() { return (unsigned)__builtin_amdgcn_s_getreg((3 << 11) | 20) & 0xFu; }
#define XB_SPIN(cond, bar) do { unsigned _sp = 0; while (cond) { __builtin_amdgcn_s_sleep(1); \
    if ((++_sp & 255u) == 0u) { if (xb_ld(&(bar)[XB_TMO])) break; if (_sp > XB_SPIN_CAP) { atomicAdd(&(bar)[XB_TMO], 1u); break; } } } } while (0)

struct XcdBarrier { unsigned* bar; unsigned x; volatile LAS unsigned* st; };

DI XcdBarrier xcd_barrier_post(unsigned* bar, volatile LAS unsigned* st) {
  XcdBarrier b; b.bar = bar; b.x = xb_xcc_id(); b.st = st;
  if (threadIdx.x == 0) (void)xb_add(&bar[XB_XCNT(b.x)], 1u);
  return b;
}
DI void xcd_barrier_complete(unsigned* bar, unsigned x, unsigned& nloc, unsigned& nx) {
  const unsigned G = gridDim.x * gridDim.y * gridDim.z;
  unsigned sum, cnt, mine, sp = 0u;
  for (;;) {
    sum = 0u; cnt = 0u; mine = 0u;
#pragma unroll
    for (unsigned j = 0; j < 16; ++j) { const unsigned c = xb_ld(&bar[XB_XCNT(j)]); sum += c; cnt += (c > 0u) ? 1u : 0u; mine = (j == x) ? c : mine; }
    if (sum == G) break;
    __builtin_amdgcn_s_sleep(1);
    if ((++sp & 255u) == 0u) { if (xb_ld(&bar[XB_TMO])) break; if (sp > XB_SPIN_CAP) { atomicAdd(&bar[XB_TMO], 1u); break; } }
  }
  nloc = mine > 0u ? mine : 1u; nx = cnt > 0u ? cnt : 1u;
}
DI void xcd_barrier(const XcdBarrier& b) {
  asm volatile("s_waitcnt vmcnt(0)" ::: "memory");
  __syncthreads();
  if (threadIdx.x == 0) {
    unsigned* bar = b.bar;
    __builtin_amdgcn_s_waitcnt(0);
    unsigned nloc = b.st[0], nx = b.st[1];
    if (nloc == 0u) { xcd_barrier_complete(bar, b.x, nloc, nx); b.st[0] = nloc; b.st[1] = nx; }
    const unsigned old = xb_add(&bar[XB_XSUB(b.x)], 1u);
    const unsigned gen = old / nloc;
    if (old + 1u == (gen + 1u) * nloc) {
      __builtin_amdgcn_fence(__ATOMIC_RELEASE, "agent");
      asm volatile("s_waitcnt vmcnt(0)" ::: "memory");
      const unsigned og = xb_add(&bar[XB_TOP], 1u);
      const unsigned tg = og / nx;
      if (og + 1u == (tg + 1u) * nx) xb_add(&bar[XB_TOPGEN], 1u);
      else XB_SPIN(xb_ld(&bar[XB_TOPGEN]) == tg, bar);
      __builtin_amdgcn_fence(__ATOMIC_ACQUIRE, "agent");
      xb_add(&bar[XB_XGEN(b.x)], 1u);
      asm volatile("s_waitcnt vmcnt(0)" ::: "memory");
    } else {
      XB_SPIN(xb_ld(&bar[XB_XGEN(b.x)]) == gen, bar);
      __builtin_amdgcn_fence(__ATOMIC_ACQUIRE, "agent");
      asm volatile("s_waitcnt vmcnt(0)" ::: "memory");
    }
  }
  __syncthreads();
}

DI void phase_even(const Params& p, int e, int sub, char* smem) {
  const int layer = 2 * e;
  u16* W = (u16*)(p.ws + OFF_W);
  u16* hbuf = (u16*)(p.ws + OFF_H);
  u16* abuf = (u16*)(p.ws + OFF_A);
  u16* uvbuf = (u16*)(p.ws + OFF_UV);
  u16* gbuf = (u16*)(p.ws + OFF_GATE);
  u16* vT = (u16*)(p.ws + OFF_VTE);
  if (sub == 0) {
    EpiE1 epi{abuf, uvbuf, gbuf, p.out + OUT_SPP + (size_t)e * 2 * 15 * 1024, p.out + OUT_SPS + (size_t)e * 16 * 15 * 1024};
    bool pre = false;
    for (int t = get_bid(); t < 132 * 40; t += gridDim.x) {
      const int tm = t / 40, tn = t % 40;
      const int t2 = t + gridDim.x, tm2 = t2 / 40, tn2 = t2 % 40;
      const bool nx = t2 < 132 * 40;
      gemm_tile<4>(hbuf + (size_t)tm * 128 * 1024, 1024, W + WE_IN + (size_t)tn * 128 * 1024, 1024, 1024, smem, tm * 128, tn * 128, epi, pre,
                   nx ? hbuf + (size_t)tm2 * 128 * 1024 : nullptr, W + WE_IN + (size_t)tn2 * 128 * 1024);
      pre = nx;
    }
  } else if (sub == 1) {
    sgu_ln_items(p, e, smem);
    pool_d_items(p, e);
  } else if (sub == 2) {
    for (int t = get_bid(); t < 1056 + 1152; t += gridDim.x) {
      if (t < 1056) {
        const int g = t / 264, r = t % 264, tm = r >> 1, tn = r & 1;
        EpiPool epi{p.pool_scale + e * 1024, gbuf, g};
        gemm_tile<4>(hbuf + (size_t)tm * 128 * 1024 + g * 256, 1024, W + WE_POOL + (size_t)g * 65536 + (size_t)tn * 128 * 256, 256, 256, smem,
                     tm * 128, tn * 128, epi);
      } else {
        const int u = t - 1056, c = u >> 3, g = (u >> 1) & 3, tn = u & 1;
        EpiSgu epi{p.b_spatial + (e * 4 + g) * 128, uvbuf, gbuf, g, c < 128 ? c * 128 : M_PROMPT + (c - 128) * 32, c < 128 ? 128 : 32};
        gemm_tile<4>(W + WE_WS + (size_t)g * 16384, 128, vT + ((size_t)c * 1024 + g * 256 + tn * 128) * 128, 128, 128, smem, 0, tn * 128, epi);
      }
    }
  } else if (sub == 3) {
    EpiBF16 epi{(u16*)(p.ws + OFF_UV), 1024};
    for (int t = get_bid(); t < 512 + 64; t += gridDim.x) {
      if (t < 512) {
        const int tm = t >> 3, tn = t & 7;
        gemm_dma<256>(gbuf + (size_t)tm * 256 * 2048, 2048, W + WE_OUT + (size_t)tn * 128 * 2048, 2048, 2048, smem, tm * 256, tn * 128, epi);
      } else {
        const int u = t - 512, tm = u >> 3, tn = u & 7, m0 = M_PROMPT + tm * 64;
        gemm_tile<2>(gbuf + (size_t)m0 * 2048, 2048, W + WE_OUT + (size_t)tn * 128 * 2048, 2048, 2048, smem, m0, tn * 128, epi);
      }
    }
  } else {
    resid_norm(p, layer, (const u16*)(p.ws + OFF_UV));
    convert_weights(p, layer + 1, smem);
  }
}

DI void knope_tile(const Params& p, int u, char* smem) {
  const u16* W = (const u16*)(p.ws + OFF_W);
  const u16* ckvb = (const u16*)(p.ws + OFF_CKVB);
  EpiBF16 ek{(u16*)(p.ws + OFF_KN), 1024};
  const int tm = u >> 3, tn = u & 7;
  gemm_dma<256>(ckvb + (size_t)tm * 256 * 256, 256, W + WO_KV + (size_t)tn * 128 * 256, 256, 256, smem, tm * 256, tn * 128, ek);
}

DI void phase_odd(const Params& p, int o, int sub, char* smem) {
  const int layer = 2 * o + 1;
  u16* W = (u16*)(p.ws + OFF_W);
  u16* hbuf = (u16*)(p.ws + OFF_H);
  u16* ckvb = (u16*)(p.ws + OFF_CKVB);
  if (sub == 0) {
    EpiO1 epi{(float*)(p.ws + OFF_ZQ), (u16*)(p.ws + OFF_GO)};
    bool pre = false;
    for (int t = get_bid(); t < 132 * 14; t += gridDim.x) {
      const int tm = t / 14, tn = t % 14;
      const int t2 = t + gridDim.x, tm2 = t2 / 14, tn2 = t2 % 14;
      const bool nx = t2 < 132 * 14;
      gemm_tile<4>(hbuf + (size_t)tm * 128 * 1024, 1024, W + WO_IN + (size_t)tn * 128 * 1024, 1024, 1024, smem, tm * 128, tn * 128, epi, pre,
                   nx ? hbuf + (size_t)tm2 * 128 * 1024 : nullptr, W + WO_IN + (size_t)tn2 * 128 * 1024);
      pre = nx;
    }
  } else if (sub == 1) {
    odd_rows(p, o);
  } else if (sub == 2) {
    EpiQup eq{(const float2*)(p.ws + OFFB_ROPE), (u16*)(p.ws + OFF_ZQ)};
    const u16* qn = (const u16*)(p.ws + OFF_QN);
    bool pre = false;
    for (int t = get_bid(); t < 1584 + 256; t += gridDim.x) {
      if (t < 1584) {
        const int tm = t / 12, tn = t % 12;
        const int t2 = t + gridDim.x, tm2 = t2 / 12, tn2 = t2 % 12;
        const bool nx = t2 < 1584;
        gemm_tile<4>(qn + (size_t)tm * 128 * 384, 384, W + WO_Q + (size_t)tn * 128 * 384, 384, 384, smem, tm * 128, tn * 128, eq, pre,
                     nx ? qn + (size_t)tm2 * 128 * 384 : nullptr, W + WO_Q + (size_t)tn2 * 128 * 384);
        pre = nx;
      } else {
        knope_tile(p, t - 1584, smem);
      }
    }
  } else if (sub == 3) {
    u16* vtb = (u16*)(p.ws + OFF_VTO);
    for (int t = get_bid(); t < 1088 + 832; t += gridDim.x) {
      if (t < 1088) {
        int b, tm, tn; long kv0, ld; u16* C;
        if (t < 512) { b = t >> 8; const int r = t & 255; tm = r >> 6; tn = r & 63; kv0 = (long)b * 8192; ld = 8192; C = vtb + (size_t)b * 1024 * 8192; }
        else { const int u = t - 512; b = u / 36; const int r = u % 36; tm = r / 9; tn = r % 9; kv0 = (long)M_PROMPT + (long)b * KSTR_S; ld = KSTR_S;
               C = vtb + (size_t)2 * 1024 * 8192 + (size_t)b * 1024 * KSTR_S; }
        EpiVT ev{C, ld};
        gemm_dma<256>(W + WO_KV + (size_t)(1024 + tm * 256) * 256, 256, ckvb + (size_t)(kv0 + tn * 128) * 256, 256, 256, smem, tm * 256, tn * 128, ev);
      } else {
        knope_tile(p, 256 + (t - 1088), smem);
      }
    }
  } else if (sub == 4) {
#if PROBE_ATTN
    attn_phase(p, smem, true);
#endif
    attn_phase(p, smem, false);
  } else if (sub == 5) {
    EpiBF16 epi{(u16*)(p.ws + OFF_KN), 1024};
    const u16* ao = (const u16*)(p.ws + OFF_GO);
    for (int t = get_bid(); t < 512 + 64; t += gridDim.x) {
      if (t < 512) {
        const int tm = t >> 3, tn = t & 7;
        gemm_dma<256>(ao + (size_t)tm * 256 * 1024, 1024, W + WO_O + (size_t)tn * 128 * 1024, 1024, 1024, smem, tm * 256, tn * 128, epi);
      } else {
        const int u = t - 512, tm = u >> 3, tn = u & 7, m0 = M_PROMPT + tm * 64;
        gemm_tile<2>(ao + (size_t)m0 * 1024, 1024, W + WO_O + (size_t)tn * 128 * 1024, 1024, 1024, smem, m0, tn * 128, epi);
      }
    }
  } else {
    resid_norm(p, layer, (const u16*)(p.ws + OFF_KN));
    if (layer < 3) convert_weights(p, layer + 1, smem);
  }
}

DI void run_phase(const Params& p, int ph, char* smem) {
  if (ph == 0) { convert_weights(p, 0, smem); prenorm0(p); }
  else if (ph <= 5) phase_even(p, 0, ph - 1, smem);
  else if (ph <= 12) phase_odd(p, 0, ph - 6, smem);
  else if (ph <= 17) phase_even(p, 1, ph - 13, smem);
  else phase_odd(p, 1, ph - 18, smem);
}

#if !USE_COOP
__global__ void __launch_bounds__(256, 2) k_phase(Params p, int ph) {
  __shared__ __attribute__((aligned(16))) char smem[81920];
  run_phase(p, ph, smem);
}
#endif

#if USE_COOP
__global__ void __launch_bounds__(256, 2) k_mega(Params p) {
  __shared__ __attribute__((aligned(16))) char smem[81920];
  cg::grid_group grid = cg::this_grid();
  if (threadIdx.x == 0) *(uint4*)(smem + 81904) = make_uint4(0u, 0u, 0u, 0u);
  __syncthreads();
  XcdBarrier xb = xcd_barrier_post((unsigned*)(p.ws + OFFB_BAR), (volatile LAS unsigned*)(smem + 81904));
#pragma unroll 1
  for (int ph = 0; ph < NPHASE; ++ph) {
    run_phase(p, ph, smem);
    if (ph + 1 < NPHASE) xcd_barrier(xb);
    if (p.out == nullptr) grid.sync();
  }
}
#endif

extern "C" void kernel_launch(void* const* d_in, const int* in_sizes, int n_in, void* d_out, int out_size, void* d_ws,
                              size_t ws_size, hipStream_t stream) {
  (void)in_sizes; (void)n_in; (void)out_size;
  if (ws_size < 268435456ull) { fprintf(stderr, "ws too small: %zu\n", ws_size); return; }
  Params p{};
  p.x_prompt = (const float*)d_in[0]; p.x_sample = (const float*)d_in[1]; p.cache_pool = (const float*)d_in[2];
  p.cache_ckv = (const float*)d_in[3]; p.cache_krope = (const float*)d_in[4]; p.norm_pre = (const float*)d_in[5];
  p.norm_post = (const float*)d_in[6]; p.w_in_even = (const float*)d_in[7]; p.w_pool = (const float*)d_in[8];
  p.pool_scale = (const float*)d_in[9]; p.sgu_ln_g = (const float*)d_in[10]; p.sgu_ln_b = (const float*)d_in[11];
  p.w_spatial = (const float*)d_in[12]; p.b_spatial = (const float*)d_in[13]; p.w_out_even = (const float*)d_in[14];
  p.w_in_odd = (const float*)d_in[15]; p.q_norm = (const float*)d_in[16]; p.kv_norm = (const float*)d_in[17];
  p.w_q_up = (const float*)d_in[18]; p.w_kv_up = (const float*)d_in[19]; p.w_o = (const float*)d_in[20];
  p.out = (float*)d_out; p.ws = (char*)d_ws;
#if USE_COOP
  static int grid_blocks = 0;
  if (!grid_blocks) {
    int dev = 0, cus = 0, per_cu = 0;
    (void)hipGetDevice(&dev);
    (void)hipDeviceGetAttribute(&cus, hipDeviceAttributeMultiprocessorCount, dev);
    (void)hipOccupancyMaxActiveBlocksPerMultiprocessor(&per_cu, k_mega, 256, 0);
    if (per_cu > 2) per_cu = 2;
    if (per_cu < 1) per_cu = 1;
    grid_blocks = cus * per_cu;
  }
  (void)hipMemsetAsync((char*)d_ws + OFFB_BAR, 0, XCD_BAR_WORDS * 4, stream);
  void* args[] = {&p};
  hipError_t e = hipLaunchCooperativeKernel((void*)k_mega, dim3(grid_blocks), dim3(256), args, 0, stream);
  if (e != hipSuccess) fprintf(stderr, "cooperative launch failed: %s (grid %d)\n", hipGetErrorString(e), grid_blocks);
#else
  for (int ph = 0; ph < NPHASE; ++ph) hipLaunchKernelGGL(k_phase, dim3(512), dim3(256), 0, stream, p, ph);
#endif
}
```

```cpp
#include <hip/hip_runtime.h>
#include <hip/hip_cooperative_groups.h>
#include <cstdio>
namespace cg = cooperative_groups;

typedef unsigned short u16;
using bf16x8 = __attribute__((ext_vector_type(8))) short;
using f32x4 = __attribute__((ext_vector_type(4))) float;
using f32x16 = __attribute__((ext_vector_type(16))) float;
using u32x4 = __attribute__((ext_vector_type(4))) unsigned;
using u32x2 = __attribute__((ext_vector_type(2))) unsigned;
#define DI __device__ __forceinline__

#ifndef USE_COOP
#define USE_COOP 1
#endif
#ifndef PROBE_ATTN
#define PROBE_ATTN 0
#endif
#ifndef PROBE_GEMM
#define PROBE_GEMM 0
#endif

constexpr int M_TOK = 16896;
constexpr int M_PROMPT = 16384;
constexpr int KSTR_S = 1152;
constexpr int KVR = 16384 + 16 * KSTR_S;
constexpr int NPHASE = 25;
constexpr float QSCALE = 0.07216878364870322f * 1.4426950408889634f;

constexpr size_t OFF_W = 0;
constexpr size_t OFF_H = 16777216;
constexpr size_t SZ_H = 34603008;
constexpr size_t OFF_A = OFF_H + SZ_H;
constexpr size_t OFF_UV = OFF_A + SZ_H;
constexpr size_t OFF_GATE = OFF_UV + 69206016;
constexpr size_t OFF_VTE = OFF_GATE + 69206016;
constexpr size_t OFF_CKVB = OFF_H;
constexpr size_t OFF_QN = OFF_H + 17825792;
constexpr size_t OFF_VTO = OFF_QN;
constexpr size_t OFF_ZQ = OFF_VTO + 71303168;
constexpr size_t OFF_GO = OFF_ZQ + 51904512;
constexpr size_t OFF_KN = OFF_GO + 34603008;
constexpr size_t WS_NEED = OFF_KN + 71303168;
static_assert(WS_NEED <= 268435456, "ws");
static_assert(OFF_VTE + 37748736 <= 268435456, "ws");
constexpr size_t WE_IN = 0, WE_OUT = 5242880, WE_POOL = 7340032, WE_WS = 7602176;
constexpr size_t WO_IN = 0, WO_Q = 1835008, WO_KV = 2424832, WO_O = 2949120;
constexpr size_t OFFB_ROPE = 7995392, OFFB_KROPEB = 10092544;
constexpr size_t OUT_SPP = 17301504, OUT_SPS = 17362944, OUT_SGUV = 17854464, OUT_CKVP = 18903040,
                 OUT_KRP = 27291648, OUT_CKVS = 29388800, OUT_KRS = 29650944;

struct Params {
  const float *x_prompt, *x_sample, *cache_pool, *cache_ckv, *cache_krope, *norm_pre, *norm_post,
      *w_in_even, *w_pool, *pool_scale, *sgu_ln_g, *sgu_ln_b, *w_spatial, *b_spatial, *w_out_even,
      *w_in_odd, *q_norm, *kv_norm, *w_q_up, *w_kv_up, *w_o;
  float* out;
  char* ws;
};

DI int get_tid() { int t = threadIdx.x; asm volatile("" : "+v"(t)); return t; }
DI int get_bid() { int b = blockIdx.x; asm volatile("" : "+s"(b)); return b; }
DI float zero_f() { float z = 0.f; asm volatile("" : "+v"(z)); return z; }
DI u16 f2bf(float x) { unsigned u = __float_as_uint(x); u += 0x7fffu + ((u >> 16) & 1u); return (u16)(u >> 16); }
DI float bf2f(u16 v) { return __uint_as_float(((unsigned)v) << 16); }
typedef __bf16 bf16x2_t __attribute__((ext_vector_type(2)));
typedef float f32x2_t __attribute__((ext_vector_type(2)));
DI unsigned pk2(float a, float b) { f32x2_t f = {a, b}; return __builtin_bit_cast(unsigned, __builtin_convertvector(f, bf16x2_t)); }
DI float bflo(unsigned u) { return __uint_as_float(u << 16); }
DI float bfhi(unsigned u) { return __uint_as_float(u & 0xffff0000u); }
DI float wave_sum(float v) {
#pragma unroll
  for (int o = 32; o; o >>= 1) v += __shfl_xor(v, o, 64);
  return v;
}
DI float gelu_f(float x) { return 0.5f * x * (1.f + erff(x * 0.70710678118654752f)); }
DI float silu_f(float x) { return x * __builtin_amdgcn_rcpf(1.f + __expf(-x)); }
DI int tok_pos(int m) { return m < M_PROMPT ? (m & 8191) : 1024 + ((m - M_PROMPT) & 31); }

DI void dma16(const void* gsrc, unsigned lds_dst) {
  unsigned keep;
  asm volatile("s_mov_b32 %0, m0\n\ts_mov_b32 m0, %2\n\ts_nop 0\n\tglobal_load_lds_dwordx4 %1, off\n\ts_mov_b32 m0, %0"
               : "=&s"(keep) : "v"(gsrc), "s"(lds_dst) : "memory");
}
template <int MT, class Epi>
DI void gemm_tile(const u16* __restrict__ X, long ldx, const u16* __restrict__ W, long ldw, int K, char* smem,
                  int m0, int n0, const Epi& epi, bool pre = false, const u16* Xn = nullptr, const u16* Wn = nullptr) {
  const int tid = get_tid(), lane = tid & 63, wave = tid >> 6;
  const int wm = wave & 1, wn = wave >> 1;
  const int lr = lane & 15, g = lane >> 4;
  const int rsw = (lr >> 1) & 7;
  f32x4 acc[4][MT];
  { const float z = zero_f();
#pragma unroll
  for (int a = 0; a < 4; ++a)
#pragma unroll
    for (int b = 0; b < MT; ++b) acc[a][b] = (f32x4){z, z, z, z}; }
  const int wu = __builtin_amdgcn_readfirstlane(wave);
  const unsigned sbase = (unsigned)__builtin_amdgcn_readfirstlane((int)(unsigned)(size_t)smem);
  const int r8 = lane >> 3, c0 = (lane & 7) ^ (r8 >> 1);
  const long oxe = (long)(wu * MT * 8 + r8) * ldx + (c0 << 3), oxo = (long)(wu * MT * 8 + r8) * ldx + ((c0 ^ 4) << 3);
  const long owe = (long)(wu * 32 + r8) * ldw + (c0 << 3), owo = (long)(wu * 32 + r8) * ldw + ((c0 ^ 4) << 3);
  const u16 *xe = X + oxe, *xo = X + oxo, *we = W + owe, *wo = W + owo;
  const long ldx8 = 8 * ldx, ldw8 = 8 * ldw;
  const unsigned xdst = sbase + wu * MT * 1024, wdst = sbase + 16384 + wu * 4096;
#define GT_DMA(BUFOFF)                                                                                          \
  {                                                                                                            \
    _Pragma("unroll") for (int i = 0; i < MT; ++i) dma16(((i & 1) ? xo : xe) + i * ldx8, xdst + (BUFOFF) + i * 1024); \
    _Pragma("unroll") for (int i = 0; i < 4; ++i) dma16(((i & 1) ? wo : we) + i * ldw8, wdst + (BUFOFF) + i * 1024);  \
    xe += 64; xo += 64; we += 64; wo += 64;                                                                    \
  }
  if (!pre) {
    __syncthreads();
    GT_DMA(0u)
  } else {
    xe += 64; xo += 64; we += 64; wo += 64;
  }
  const int nk = K >> 6;
  int kt = 0;
  do {
    asm volatile("s_waitcnt vmcnt(0)" ::: "memory");
    __syncthreads();
    if (kt + 1 < nk) GT_DMA((unsigned)((kt + 1) & 1) * 32768u)
    else if (Xn != nullptr) { xe = Xn + oxe; xo = Xn + oxo; we = Wn + owe; wo = Wn + owo; GT_DMA(0u) }
    const char* cur = smem + (kt & 1) * 32768;
#pragma unroll
    for (int ks = 0; ks < 2; ++ks) {
      bf16x8 xf[MT], wf[4];
      const int ch = ((ks * 4 + g) ^ rsw) << 4;
#pragma unroll
      for (int i = 0; i < MT; ++i) xf[i] = *(const bf16x8*)(cur + (wm * 16 * MT + i * 16 + lr) * 128 + ch);
#pragma unroll
      for (int i = 0; i < 4; ++i) wf[i] = *(const bf16x8*)(cur + 16384 + (wn * 64 + i * 16 + lr) * 128 + ch);
#pragma unroll
      for (int nt = 0; nt < 4; ++nt)
#pragma unroll
        for (int mt = 0; mt < MT; ++mt)
          acc[nt][mt] = __builtin_amdgcn_mfma_f32_16x16x32_bf16(wf[nt], xf[mt], acc[nt][mt], 0, 0, 0);
    }
  } while (++kt < nk);
#undef GT_DMA
  epi.run(acc, m0 + wm * 16 * MT + lr, n0 + wn * 64 + 4 * g);
}

template <int N> DI void wait_vm() { asm volatile("s_waitcnt vmcnt(%0)" ::"n"(N) : "memory"); }

template <int BM, class Epi>
DI void gemm_dma(const u16* __restrict__ X, long ldx, const u16* __restrict__ W, long ldw, int K, char* smem,
                 int m0, int n0, const Epi& epi) {
  constexpr bool BIG = (BM == 256);
  constexpr int D = BIG ? 3 : 4;
  constexpr int STG = BM * 64 + 8192;
  constexpr int MT = BIG ? 4 : BM / 32;
  constexpr int NT = BIG ? 8 : 4;
  constexpr int XD = BM / 64;
  constexpr int PW = XD + 2;
  const int tid = get_tid(), lane = tid & 63, wave = tid >> 6;
  const int lr = lane & 15, g = lane >> 4;
  const int rd = lr * 64 + ((g ^ ((4 - (lr >> 2)) & 3)) << 4);
  const int xrow0 = BIG ? wave * 64 : (wave & 1) * (BM / 2);
  const int wrow0 = BIG ? 0 : (wave >> 1) * 64;
  f32x4 acc[NT][MT];
  { const float z = zero_f();
#pragma unroll
  for (int a = 0; a < NT; ++a)
#pragma unroll
    for (int b = 0; b < MT; ++b) acc[a][b] = (f32x4){z, z, z, z}; }
  const int wu = __builtin_amdgcn_readfirstlane(wave);
  const unsigned sbase = (unsigned)__builtin_amdgcn_readfirstlane((int)(unsigned)(size_t)smem);
  const int r16 = lane >> 2, chunk = (lane & 3) ^ ((4 - (r16 >> 2)) & 3);
  const u16* xs = X + (long)(wu * XD * 16 + r16) * ldx + (chunk << 3);
  const u16* ws = W + (long)(wu * 32 + r16) * ldw + (chunk << 3);
  const long ldx16 = 16 * ldx, ldw16 = 16 * ldw;
  const unsigned xdst = sbase + wu * XD * 1024, wdst = sbase + BM * 64 + wu * 2048;
#define GD_ISSUE(BUF)                                                                                           \
  {                                                                                                            \
    _Pragma("unroll") for (int i = 0; i < XD; ++i) dma16(xs + i * ldx16, xdst + (unsigned)(BUF) * STG + i * 1024); \
    _Pragma("unroll") for (int i = 0; i < 2; ++i) dma16(ws + i * ldw16, wdst + (unsigned)(BUF) * STG + i * 1024);  \
    xs += 32; ws += 32;                                                                                        \
  }
  const int nk = K >> 5;
  __syncthreads();
#pragma unroll
  for (int s = 0; s < D - 1; ++s) GD_ISSUE(s)
  int cur = 0, nxt = D - 1, kt = 0;
  do {
    if (kt + D - 2 < nk) wait_vm<PW * (D - 2)>(); else wait_vm<0>();
    __syncthreads();
    if (kt + D - 1 < nk) GD_ISSUE(nxt)
    nxt = (nxt + 1 == D) ? 0 : nxt + 1;
    const char* base = smem + cur * STG;
    cur = (cur + 1 == D) ? 0 : cur + 1;
    bf16x8 xf[MT];
#pragma unroll
    for (int i = 0; i < MT; ++i) xf[i] = *(const bf16x8*)(base + (xrow0 + i * 16) * 64 + rd);
#pragma unroll
    for (int nh = 0; nh < NT / 4; ++nh) {
      bf16x8 wf[4];
#pragma unroll
      for (int i = 0; i < 4; ++i) wf[i] = *(const bf16x8*)(base + BM * 64 + (wrow0 + (nh * 4 + i) * 16) * 64 + rd);
#pragma unroll
      for (int i = 0; i < 4; ++i)
#pragma unroll
        for (int mt = 0; mt < MT; ++mt)
          acc[nh * 4 + i][mt] = __builtin_amdgcn_mfma_f32_16x16x32_bf16(wf[i], xf[mt], acc[nh * 4 + i][mt], 0, 0, 0);
    }
  } while (++kt < nk);
#undef GD_ISSUE
  epi.run(acc, m0 + xrow0 + lr, n0 + wrow0 + 4 * g);
}

template <class Epi>
DI void gemm_big(const u16* __restrict__ X, long ldx, const u16* __restrict__ W, long ldw, int K, char* smem,
                 int m0, int n0, const Epi& epi) {
  const int tid = get_tid(), lane = tid & 63, wave = tid >> 6;
  const int lr = lane & 15, g = lane >> 4;
  const int rsw = (lr >> 1) & 7;
  const int rd0 = lr * 128 + (((2 * g) ^ rsw) << 4), rd1 = lr * 128 + (((2 * g + 1) ^ rsw) << 4);
  f32x4 acc[8][4];
  { const float z = zero_f();
#pragma unroll
  for (int a = 0; a < 8; ++a)
#pragma unroll
    for (int b = 0; b < 4; ++b) acc[a][b] = (f32x4){z, z, z, z}; }
  const u16* xp = X + (long)(wave * 64 + lr) * ldx + 16 * g;
  const long ldx16 = 16 * ldx;
  const int wrow = wave * 8 + (lane >> 3);
  const u16* wp = W + (long)wrow * ldw + (((lane & 7) ^ ((wrow >> 1) & 7)) << 3);
  const long ldw32 = 32 * ldw;
  const int wdst = tid * 16;
  bf16x8 xa[4], xb[4];
  __syncthreads();
#pragma unroll
  for (int i = 0; i < 4; ++i)
    __builtin_amdgcn_global_load_lds((const unsigned*)(wp + i * ldw32), (unsigned*)(smem + wdst + i * 4096), 16, 0, 0);
#pragma unroll
  for (int mt = 0; mt < 4; ++mt) { xa[mt] = *(const bf16x8*)(xp + mt * ldx16); xb[mt] = *(const bf16x8*)(xp + mt * ldx16 + 8); }
  __syncthreads();
  const int nk = K >> 6;
  int kt = 0;
  do {
    const char* cur = smem + (kt & 1) * 16384;
    char* nxt = smem + ((kt & 1) ^ 1) * 16384;
    const int adv = (kt + 1 < nk) ? 64 : 0;
    xp += adv; wp += adv;
#pragma unroll
    for (int i = 0; i < 4; ++i)
      __builtin_amdgcn_global_load_lds((const unsigned*)(wp + i * ldw32), (unsigned*)(nxt + wdst + i * 4096), 16, 0, 0);
#pragma unroll
    for (int nh = 0; nh < 2; ++nh) {
      bf16x8 wf[4];
#pragma unroll
      for (int i = 0; i < 4; ++i) wf[i] = *(const bf16x8*)(cur + rd0 + (nh * 4 + i) * 2048);
#pragma unroll
      for (int i = 0; i < 4; ++i)
#pragma unroll
        for (int mt = 0; mt < 4; ++mt)
          acc[nh * 4 + i][mt] = __builtin_amdgcn_mfma_f32_16x16x32_bf16(wf[i], xa[mt], acc[nh * 4 + i][mt], 0, 0, 0);
    }
#pragma unroll
    for (int mt = 0; mt < 4; ++mt) xa[mt] = *(const bf16x8*)(xp + mt * ldx16);
#pragma unroll
    for (int nh = 0; nh < 2; ++nh) {
      bf16x8 wf[4];
#pragma unroll
      for (int i = 0; i < 4; ++i) wf[i] = *(const bf16x8*)(cur + rd1 + (nh * 4 + i) * 2048);
#pragma unroll
      for (int i = 0; i < 4; ++i)
#pragma unroll
        for (int mt = 0; mt < 4; ++mt)
          acc[nh * 4 + i][mt] = __builtin_amdgcn_mfma_f32_16x16x32_bf16(wf[i], xb[mt], acc[nh * 4 + i][mt], 0, 0, 0);
    }
#pragma unroll
    for (int mt = 0; mt < 4; ++mt) xb[mt] = *(const bf16x8*)(xp + mt * ldx16 + 8);
    __syncthreads();
  } while (++kt < nk);
  epi.run(acc, m0 + wave * 64 + lr, n0 + 4 * g);
}

DI void st_bf4(u16* p, float a, float b, float c, float d) { *(uint2*)p = make_uint2(pk2(a, b), pk2(c, d)); }

struct EpiE1 {
  u16 *abuf, *uvbuf, *gatebuf; float *spp, *sps;
  template <int NT, int MT> DI void run(f32x4 (&acc)[NT][MT], int mb, int nb) const {
#pragma unroll
    for (int nt = 0; nt < NT; ++nt) {
      const int n = nb + nt * 16;
#pragma unroll
      for (int mt = 0; mt < MT; ++mt) {
        const int m = mb + mt * 16;
        f32x4 v = acc[nt][mt];
        if (n < 1024) {
          st_bf4(abuf + (size_t)m * 1024 + n, v[0], v[1], v[2], v[3]);
          float* dst = nullptr;
          if (m < M_PROMPT) { int t = m & 8191; if (t >= 8177) dst = spp + ((size_t)((m >> 13) * 15 + (t - 8177))) * 1024 + n; }
          else { int r = m - M_PROMPT; int s = r & 31; if (s >= 17) dst = sps + ((size_t)((r >> 5) * 15 + (s - 17))) * 1024 + n; }
          if (dst) *(float4*)dst = make_float4(v[0], v[1], v[2], v[3]);
        } else if (n < 3072) {
          st_bf4(uvbuf + (size_t)m * 2048 + (n - 1024), gelu_f(v[0]), gelu_f(v[1]), gelu_f(v[2]), gelu_f(v[3]));
        } else {
          st_bf4(gatebuf + (size_t)m * 2048 + (n - 3072), silu_f(v[0]), silu_f(v[1]), silu_f(v[2]), silu_f(v[3]));
        }
        __builtin_amdgcn_sched_barrier(0);
      }
    }
  }
};

struct EpiPool {
  const float* scale; u16* mix; int g;
  template <int NT, int MT> DI void run(f32x4 (&acc)[NT][MT], int mb, int nb) const {
#pragma unroll
    for (int nt = 0; nt < NT; ++nt) {
      const int ch = g * 256 + nb + nt * 16;
      const float4 sc = *(const float4*)(scale + ch);
#pragma unroll
      for (int mt = 0; mt < MT; ++mt) {
        const int m = mb + mt * 16;
        u16* q = mix + (size_t)m * 2048 + ch;
        const uint2 gt = *(const uint2*)q;
        f32x4 v = acc[nt][mt];
        st_bf4(q, v[0] * sc.x * bflo(gt.x), v[1] * sc.y * bfhi(gt.x), v[2] * sc.z * bflo(gt.y), v[3] * sc.w * bfhi(gt.y));
      }
    }
  }
};

struct EpiSgu {
  const float* bs; const u16* uv; u16* mix; int g, rowbase, nvalid;
  template <int NT, int MT> DI void run(f32x4 (&acc)[NT][MT], int mb, int nb) const {
#pragma unroll
    for (int mt = 0; mt < MT; ++mt) {
      const int i = mb + mt * 16;
      if (i < nvalid) {
        const float bias = bs[i];
        const size_t row = (size_t)(rowbase + i);
#pragma unroll
        for (int nt = 0; nt < NT; ++nt) {
          const int ch = g * 256 + nb + nt * 16;
          const uint2 uu = *(const uint2*)(uv + row * 2048 + ch);
          u16* q = mix + row * 2048 + 1024 + ch;
          const uint2 gt = *(const uint2*)q;
          f32x4 v = acc[nt][mt];
          st_bf4(q, (v[0] + bias) * bflo(uu.x) * bflo(gt.x), (v[1] + bias) * bfhi(uu.x) * bfhi(gt.x),
                 (v[2] + bias) * bflo(uu.y) * bflo(gt.y), (v[3] + bias) * bfhi(uu.y) * bfhi(gt.y));
        }
      }
    }
  }
};

struct EpiF32 {
  float* C; long ldc;
  template <int NT, int MT> DI void run(f32x4 (&acc)[NT][MT], int mb, int nb) const {
#pragma unroll
    for (int nt = 0; nt < NT; ++nt)
#pragma unroll
      for (int mt = 0; mt < MT; ++mt) {
        f32x4 v = acc[nt][mt];
        *(float4*)(C + (size_t)(mb + mt * 16) * ldc + nb + nt * 16) = make_float4(v[0], v[1], v[2], v[3]);
      }
  }
};

struct EpiBF16 {
  u16* C; long ldc;
  template <int NT, int MT> DI void run(f32x4 (&acc)[NT][MT], int mb, int nb) const {
#pragma unroll
    for (int nt = 0; nt < NT; ++nt)
#pragma unroll
      for (int mt = 0; mt < MT; ++mt) {
        f32x4 v = acc[nt][mt];
        st_bf4(C + (size_t)(mb + mt * 16) * ldc + nb + nt * 16, v[0], v[1], v[2], v[3]);
      }
  }
};

struct EpiVT {
  u16* C; long ldc;
  template <int NT, int MT> DI void run(f32x4 (&acc)[NT][MT], int mb, int nb) const {
#pragma unroll
    for (int nt = 0; nt < NT; ++nt) {
      const int n = nb + nt * 16;
      const int np = (n & ~12) | ((n & 4) << 1) | ((n & 8) >> 1);
#pragma unroll
      for (int mt = 0; mt < MT; ++mt) {
        f32x4 v = acc[nt][mt];
        st_bf4(C + (size_t)(mb + mt * 16) * ldc + np, v[0], v[1], v[2], v[3]);
      }
    }
  }
};

struct EpiO1 {
  float* zq; u16* gate;
  template <int NT, int MT> DI void run(f32x4 (&acc)[NT][MT], int mb, int nb) const {
#pragma unroll
    for (int nt = 0; nt < NT; ++nt) {
      const int n = nb + nt * 16;
#pragma unroll
      for (int mt = 0; mt < MT; ++mt) {
        const int m = mb + mt * 16;
        f32x4 v = acc[nt][mt];
        if (n < 704) *(float4*)(zq + (size_t)m * 704 + n) = make_float4(v[0], v[1], v[2], v[3]);
        else if (n < 1728) st_bf4(gate + (size_t)m * 1024 + (n - 704), silu_f(v[0]), silu_f(v[1]), silu_f(v[2]), silu_f(v[3]));
        __builtin_amdgcn_sched_barrier(0);
      }
    }
  }
};

struct EpiQup {
  const float2* rope; u16* q;
  template <int NT, int MT> DI void run(f32x4 (&acc)[NT][MT], int mb, int nb) const {
    const int g4 = nb & 15;
#pragma unroll
    for (int q4 = 0; q4 < NT / 4; ++q4) {
      const int grp = ((nb - g4) >> 6) + q4;
      if ((grp % 3) == 2) {
#pragma unroll
        for (int mt = 0; mt < MT; ++mt) {
          const int pos = tok_pos(mb + mt * 16);
#pragma unroll
          for (int nt = 0; nt < 2; ++nt)
#pragma unroll
            for (int j = 0; j < 4; ++j) {
              const float2 cs = rope[pos * 32 + nt * 16 + g4 + j];
              const float x1 = acc[q4 * 4 + nt][mt][j], x2 = acc[q4 * 4 + nt + 2][mt][j];
              acc[q4 * 4 + nt][mt][j] = x1 * cs.x - x2 * cs.y;
              acc[q4 * 4 + nt + 2][mt][j] = x2 * cs.x + x1 * cs.y;
            }
        }
      }
    }
#pragma unroll
    for (int nt = 0; nt < NT; ++nt)
#pragma unroll
      for (int mt = 0; mt < MT; ++mt) {
        f32x4 v = acc[nt][mt];
        st_bf4(q + (size_t)(mb + mt * 16) * 1536 + nb + nt * 16, v[0] * QSCALE, v[1] * QSCALE, v[2] * QSCALE, v[3] * QSCALE);
      }
  }
};

DI void tconv_tile(const float* __restrict__ src, long lds, int cvalid, u16* __restrict__ dst, long ldd, int r0, int c0, char* smem) {
  float (*T)[65] = (float (*)[65])smem;
  const int tid = get_tid();
  __syncthreads();
  const int lr = tid >> 4, lc = (tid & 15) * 4;
#pragma unroll
  for (int i = 0; i < 4; ++i) {
    const int r = lr + 16 * i;
    float4 v = make_float4(0.f, 0.f, 0.f, 0.f);
    if (c0 + lc < cvalid) v = *(const float4*)(src + (long)(r0 + r) * lds + c0 + lc);
    T[r][lc] = v.x; T[r][lc + 1] = v.y; T[r][lc + 2] = v.z; T[r][lc + 3] = v.w;
  }
  __syncthreads();
  const int oc = tid >> 2, seg = (tid & 3) * 16;
  unsigned pk[8];
#pragma unroll
  for (int k = 0; k < 8; ++k) pk[k] = pk2(T[seg + 2 * k][oc], T[seg + 2 * k + 1][oc]);
  uint4* d = (uint4*)(dst + (long)(c0 + oc) * ldd + r0 + seg);
  d[0] = make_uint4(pk[0], pk[1], pk[2], pk[3]);
  d[1] = make_uint4(pk[4], pk[5], pk[6], pk[7]);
}

DI void convert_weights(const Params& p, int layer, char* smem) {
  u16* W = (u16*)(p.ws + OFF_W);
  const int tid = get_tid();
  if ((layer & 1) == 0) {
    const int e = layer >> 1;
    for (int t = get_bid(); t < 1920; t += gridDim.x) {
      if (t < 1280) {
        tconv_tile(p.w_in_even + (size_t)e * 1024 * 5120, 5120, 5120, W + WE_IN, 1024, (t / 80) * 64, (t % 80) * 64, smem);
      } else if (t < 1792) {
        const int u = t - 1280;
        tconv_tile(p.w_out_even + (size_t)e * 2048 * 1024, 1024, 1024, W + WE_OUT, 2048, (u >> 4) * 64, (u & 15) * 64, smem);
      } else if (t < 1856) {
        const int u = t - 1792, g = u >> 4, v = u & 15;
        tconv_tile(p.w_pool + (size_t)(e * 4 + g) * 65536, 256, 256, W + WE_POOL + (size_t)g * 65536, 256, (v >> 2) * 64, (v & 3) * 64, smem);
      } else {
        const int idx = (t - 1856) * 1024 + tid * 4;
        const int i = (idx >> 7) & 127, j = idx & 127;
        float4 v = *(const float4*)(p.w_spatial + (size_t)e * 65536 + idx);
        if ((j >> 6) > (i >> 6)) v = make_float4(0.f, 0.f, 0.f, 0.f);
        st_bf4(W + WE_WS + idx, v.x, v.y, v.z, v.w);
      }
    }
  } else {
    const int o = layer >> 1;
    float2* rope = (float2*)(p.ws + OFFB_ROPE);
    for (int t = get_bid(); t < 2000; t += gridDim.x) {
      if (t < 448) {
        tconv_tile(p.w_in_odd + (size_t)o * 1024 * 1728, 1728, 1728, W + WO_IN, 1024, (t / 28) * 64, (t % 28) * 64, smem);
      } else if (t < 592) {
        const int u = t - 448;
        tconv_tile(p.w_q_up + (size_t)o * 384 * 1536, 1536, 1536, W + WO_Q, 384, (u / 24) * 64, (u % 24) * 64, smem);
      } else if (t < 720) {
        const int u = t - 592;
        const int c0 = (u & 31) * 64, hh = c0 >> 8, j0 = c0 & 255;
        const int drow0 = j0 < 128 ? hh * 128 + j0 : 1024 + hh * 128 + (j0 - 128);
        tconv_tile(p.w_kv_up + (size_t)o * 256 * 2048, 2048, 2048, W + WO_KV + (long)(drow0 - c0) * 256, 256, (u >> 5) * 64, c0, smem);
      } else if (t < 976) {
        const int u = t - 720;
        tconv_tile(p.w_o + (size_t)o * 1024 * 1024, 1024, 1024, W + WO_O, 1024, (u >> 4) * 64, (u & 15) * 64, smem);
      } else {
        const int idx = (t - 976) * 256 + tid;
        const int pos = idx >> 5, i = idx & 31;
        const float freq = exp2f(-(float)i * (13.287712379549449f / 32.f));
        const float ang = (float)pos * freq;
        float s, c;
        sincosf(ang, &s, &c);
        rope[idx] = make_float2(c, s);
      }
    }
  }
}

DI void prenorm0(const Params& p) {
  const int lane = get_tid() & 63;
  u16* h = (u16*)(p.ws + OFF_H);
  for (int r = get_bid() * 4 + (get_tid() >> 6); r < M_TOK; r += gridDim.x * 4) {
    const float* x = r < M_PROMPT ? p.x_prompt + (size_t)r * 1024 : p.x_sample + (size_t)(r - M_PROMPT) * 1024;
    float4 v[4]; float ss = 0.f;
#pragma unroll
    for (int i = 0; i < 4; ++i) { v[i] = *(const float4*)(x + lane * 4 + 256 * i); ss += v[i].x * v[i].x + v[i].y * v[i].y + v[i].z * v[i].z + v[i].w * v[i].w; }
    ss = wave_sum(ss);
    const float rs = rsqrtf(ss * (1.f / 1024.f) + 1e-6f);
#pragma unroll
    for (int i = 0; i < 4; ++i) {
      const float4 gg = *(const float4*)(p.norm_pre + lane * 4 + 256 * i);
      st_bf4(h + (size_t)r * 1024 + lane * 4 + 256 * i, v[i].x * rs * gg.x, v[i].y * rs * gg.y, v[i].z * rs * gg.z, v[i].w * rs * gg.w);
    }
  }
}

DI void resid_norm(const Params& p, int layer, const u16* __restrict__ y) {
  const int lane = get_tid() & 63;
  u16* h = (u16*)(p.ws + OFF_H);
  const float* gpost = p.norm_post + layer * 1024;
  const float* gpre = p.norm_pre + (layer + 1) * 1024;
  for (int r = get_bid() * 4 + (get_tid() >> 6); r < M_TOK; r += gridDim.x * 4) {
    const float* x;
    if (layer == 0) x = r < M_PROMPT ? p.x_prompt + (size_t)r * 1024 : p.x_sample + (size_t)(r - M_PROMPT) * 1024;
    else x = p.out + (size_t)r * 1024;
    float4 yv[4], xv[4]; float ss = 0.f;
#pragma unroll
    for (int i = 0; i < 4; ++i) {
      { const uint2 yq = *(const uint2*)(y + (size_t)r * 1024 + lane * 4 + 256 * i); yv[i] = make_float4(bflo(yq.x), bfhi(yq.x), bflo(yq.y), bfhi(yq.y)); }
      xv[i] = *(const float4*)(x + lane * 4 + 256 * i);
      ss += yv[i].x * yv[i].x + yv[i].y * yv[i].y + yv[i].z * yv[i].z + yv[i].w * yv[i].w;
    }
    ss = wave_sum(ss);
    const float rs = rsqrtf(ss * (1.f / 1024.f) + 1e-6f);
    float ss2 = 0.f;
#pragma unroll
    for (int i = 0; i < 4; ++i) {
      const float4 gg = *(const float4*)(gpost + lane * 4 + 256 * i);
      xv[i].x += yv[i].x * rs * gg.x; xv[i].y += yv[i].y * rs * gg.y; xv[i].z += yv[i].z * rs * gg.z; xv[i].w += yv[i].w * rs * gg.w;
      *(float4*)(p.out + (size_t)r * 1024 + lane * 4 + 256 * i) = xv[i];
      ss2 += xv[i].x * xv[i].x + xv[i].y * xv[i].y + xv[i].z * xv[i].z + xv[i].w * xv[i].w;
    }
    if (layer < 3) {
      ss2 = wave_sum(ss2);
      const float rs2 = rsqrtf(ss2 * (1.f / 1024.f) + 1e-6f);
#pragma unroll
      for (int i = 0; i < 4; ++i) {
        const float4 gg = *(const float4*)(gpre + lane * 4 + 256 * i);
        st_bf4(h + (size_t)r * 1024 + lane * 4 + 256 * i, xv[i].x * rs2 * gg.x, xv[i].y * rs2 * gg.y, xv[i].z * rs2 * gg.z, xv[i].w * rs2 * gg.w);
      }
    }
  }
}

DI void sgu_ln_items(const Params& p, int e, char* smem) {
  const int tid = get_tid(), lane = tid & 63, wave = tid >> 6;
  const u16* uv = (const u16*)(p.ws + OFF_UV);
  u16* vT = (u16*)(p.ws + OFF_VTE);
  float2* st = (float2*)smem;
  u16* T = (u16*)(smem + 1024);
  const float* lg = p.sgu_ln_g + e * 1024;
  const float* lb = p.sgu_ln_b + e * 1024;
  for (int it = get_bid(); it < 576; it += gridDim.x) {
    const int c = it >> 2, gq = it & 3;
    const int rowbase = c < 128 ? c * 128 : M_PROMPT + (c - 128) * 32;
    const int nvalid = c < 128 ? 128 : 32;
    __syncthreads();
#pragma unroll 1
    for (int b8 = 0; b8 < 32; b8 += 8) {
      u32x4 q[8][2];
#pragma unroll
      for (int k = 0; k < 8; ++k) {
        const int i = wave * 32 + b8 + k;
        const int ic = i < nvalid ? i : 0;
        const u16* src = uv + (size_t)(rowbase + ic) * 2048 + 1024 + lane * 8;
        q[k][0] = *(const u32x4*)src;
        q[k][1] = *(const u32x4*)(src + 512);
      }
#pragma unroll
      for (int k = 0; k < 8; ++k) {
        const int i = wave * 32 + b8 + k;
        float s = 0.f, s2 = 0.f;
#pragma unroll
        for (int j = 0; j < 2; ++j)
#pragma unroll
          for (int w4 = 0; w4 < 4; ++w4) {
            const float lo = bflo(q[k][j][w4]), hi = bfhi(q[k][j][w4]);
            s += lo + hi; s2 += lo * lo + hi * hi;
          }
        s = wave_sum(s); s2 = wave_sum(s2);
        const float mu = s * (1.f / 1024.f);
        const float var = fmaxf(s2 * (1.f / 1024.f) - mu * mu, 0.f);
        const float rstd = rsqrtf(var + 1e-6f);
        if (lane == 0) st[i] = i < nvalid ? make_float2(mu, rstd) : make_float2(0.f, 0.f);
      }
    }
    __syncthreads();
    const int rr = tid >> 3, cc = tid & 7;
    u32x4 ld[4][4];
#pragma unroll
    for (int sl = 0; sl < 4; ++sl)
#pragma unroll
      for (int i4 = 0; i4 < 4; ++i4) {
        const int i = rr + 32 * i4;
        const int ic = i < nvalid ? i : 0;
        ld[sl][i4] = *(const u32x4*)(uv + (size_t)(rowbase + ic) * 2048 + 1024 + gq * 256 + sl * 64 + cc * 8);
      }
#pragma unroll
    for (int sl = 0; sl < 4; ++sl) {
      const int ch = gq * 256 + sl * 64 + cc * 8;
      const float4 g0 = *(const float4*)(lg + ch), g1 = *(const float4*)(lg + ch + 4);
      const float4 b0 = *(const float4*)(lb + ch), b1 = *(const float4*)(lb + ch + 4);
#pragma unroll
      for (int i4 = 0; i4 < 4; ++i4) {
        const int i = rr + 32 * i4;
        float o[8];
        if (i < nvalid) {
          const u32x4 q = ld[sl][i4];
          const float2 ms = st[i];
          o[0] = (bflo(q[0]) - ms.x) * ms.y * g0.x + b0.x; o[1] = (bfhi(q[0]) - ms.x) * ms.y * g0.y + b0.y;
          o[2] = (bflo(q[1]) - ms.x) * ms.y * g0.z + b0.z; o[3] = (bfhi(q[1]) - ms.x) * ms.y * g0.w + b0.w;
          o[4] = (bflo(q[2]) - ms.x) * ms.y * g1.x + b1.x; o[5] = (bfhi(q[2]) - ms.x) * ms.y * g1.y + b1.y;
          o[6] = (bflo(q[3]) - ms.x) * ms.y * g1.z + b1.z; o[7] = (bfhi(q[3]) - ms.x) * ms.y * g1.w + b1.w;
          if (c >= 128) {
            float* dst = p.out + OUT_SGUV + ((size_t)(e * 16 + (c - 128)) * 32 + i) * 1024 + ch;
            *(float4*)dst = make_float4(o[0], o[1], o[2], o[3]);
            *(float4*)(dst + 4) = make_float4(o[4], o[5], o[6], o[7]);
          }
        } else {
#pragma unroll
          for (int k = 0; k < 8; ++k) o[k] = 0.f;
        }
#pragma unroll
        for (int k = 0; k < 8; ++k) T[(cc * 8 + k) * 136 + i] = f2bf(o[k]);
      }
      __syncthreads();
#pragma unroll
      for (int j = 0; j < 4; ++j) {
        const int idx = tid + 256 * j;
        const int chl = idx >> 4, pc = idx & 15;
        const uint4 q = *(const uint4*)(T + chl * 136 + pc * 8);
        *(uint4*)(vT + ((size_t)c * 1024 + gq * 256 + sl * 64 + chl) * 128 + pc * 8) = q;
      }
      __syncthreads();
    }
  }
}

template <int W>
DI void pool_d_one(const u16* __restrict__ a, u16* __restrict__ d, const float* __restrict__ hist, int r, int ch0) {
  float acc[8];
#pragma unroll
  for (int k = 0; k < 8; ++k) acc[k] = 0.f;
  u32x4 q[W];
  float cnt;
  if (r < M_PROMPT) {
    const int t = r & 8191;
#pragma unroll
    for (int i = 0; i < W; ++i) q[i] = *(const u32x4*)(a + (size_t)(r - (i < t ? i : t)) * 1024 + ch0);
#pragma unroll
    for (int i = 0; i < W; ++i) {
      const float m = i <= t ? 1.f : 0.f;
      acc[0] += m * bflo(q[i][0]); acc[1] += m * bfhi(q[i][0]); acc[2] += m * bflo(q[i][1]); acc[3] += m * bfhi(q[i][1]);
      acc[4] += m * bflo(q[i][2]); acc[5] += m * bfhi(q[i][2]); acc[6] += m * bflo(q[i][3]); acc[7] += m * bfhi(q[i][3]);
    }
    cnt = (float)(t + 1 < W ? t + 1 : W);
  } else {
    const int rr = r - M_PROMPT, b = rr >> 5, s = rr & 31;
    f32x4 h[W][2];
#pragma unroll
    for (int i = 0; i < W; ++i) {
      q[i] = *(const u32x4*)(a + (size_t)(r - (i < s ? i : s)) * 1024 + ch0);
      const int hi = 15 + s - i;
      const float* hp = hist + ((size_t)b * 15 + (hi < 0 ? 0 : (hi > 14 ? 14 : hi))) * 1024 + ch0;
      h[i][0] = *(const f32x4*)hp; h[i][1] = *(const f32x4*)(hp + 4);
    }
#pragma unroll
    for (int i = 0; i < W; ++i) {
      const float m = i <= s ? 1.f : 0.f, mh = 1.f - m;
      acc[0] += m * bflo(q[i][0]) + mh * h[i][0][0]; acc[1] += m * bfhi(q[i][0]) + mh * h[i][0][1];
      acc[2] += m * bflo(q[i][1]) + mh * h[i][0][2]; acc[3] += m * bfhi(q[i][1]) + mh * h[i][0][3];
      acc[4] += m * bflo(q[i][2]) + mh * h[i][1][0]; acc[5] += m * bfhi(q[i][2]) + mh * h[i][1][1];
      acc[6] += m * bflo(q[i][3]) + mh * h[i][1][2]; acc[7] += m * bfhi(q[i][3]) + mh * h[i][1][3];
    }
    cnt = (float)W;
  }
  const float inv = 1.f / cnt;
  const u32x4 self = q[0];
  u32x4 o;
  o[0] = pk2(acc[0] * inv - bflo(self[0]), acc[1] * inv - bfhi(self[0]));
  o[1] = pk2(acc[2] * inv - bflo(self[1]), acc[3] * inv - bfhi(self[1]));
  o[2] = pk2(acc[4] * inv - bflo(self[2]), acc[5] * inv - bfhi(self[2]));
  o[3] = pk2(acc[6] * inv - bflo(self[3]), acc[7] * inv - bfhi(self[3]));
  *(u32x4*)(d + (size_t)r * 1024 + ch0) = o;
}

DI void pool_d_items(const Params& p, int e) {
  const u16* a = (const u16*)(p.ws + OFF_A);
  u16* d = (u16*)(p.ws + OFF_H);
  const float* hist = p.cache_pool + (size_t)e * 16 * 15 * 1024;
  const int tid = get_tid(), lane = tid & 63;
  for (int wi = get_bid() * 4 + (tid >> 6); wi < (M_TOK / 2) * 4; wi += gridDim.x * 4) {
    const int g = __builtin_amdgcn_readfirstlane(wi & 3);
    const int r = (wi >> 2) * 2 + (lane >> 5), ch0 = g * 256 + (lane & 31) * 8;
    if (g == 0) pool_d_one<2>(a, d, hist, r, ch0);
    else if (g == 1) pool_d_one<4>(a, d, hist, r, ch0);
    else if (g == 2) pool_d_one<8>(a, d, hist, r, ch0);
    else pool_d_one<16>(a, d, hist, r, ch0);
  }
}

DI void odd_rows(const Params& p, int o) {
  const int tid = get_tid(), lane = tid & 63;
  const float* zq = (const float*)(p.ws + OFF_ZQ);
  u16* qn = (u16*)(p.ws + OFF_QN);
  u16* ckvb = (u16*)(p.ws + OFF_CKVB);
  u16* krb = (u16*)(p.ws + OFFB_KROPEB);
  const float2* rope = (const float2*)(p.ws + OFFB_ROPE);
  const float* qnw = p.q_norm + o * 384;
  const float* kvw = p.kv_norm + o * 256;
  for (int r = get_bid() * 4 + (tid >> 6); r < M_TOK; r += gridDim.x * 4) {
    const float* z = zq + (size_t)r * 704;
    float2 qv[3]; float ss = 0.f;
#pragma unroll
    for (int i = 0; i < 3; ++i) { qv[i] = *(const float2*)(z + lane * 2 + 128 * i); ss += qv[i].x * qv[i].x + qv[i].y * qv[i].y; }
    const float4 kv = *(const float4*)(z + 384 + lane * 4);
    float sk = kv.x * kv.x + kv.y * kv.y + kv.z * kv.z + kv.w * kv.w;
    const float kr = z[640 + lane];
    ss = wave_sum(ss); sk = wave_sum(sk);
    const float rq = rsqrtf(ss * (1.f / 384.f) + 1e-6f);
    const float rk = rsqrtf(sk * (1.f / 256.f) + 1e-6f);
#pragma unroll
    for (int i = 0; i < 3; ++i) {
      const float2 w = *(const float2*)(qnw + lane * 2 + 128 * i);
      *(unsigned*)(qn + (size_t)r * 384 + lane * 2 + 128 * i) = pk2(qv[i].x * rq * w.x, qv[i].y * rq * w.y);
    }
    size_t kvrow; float *dck, *dkr; int pos;
    if (r < M_PROMPT) {
      kvrow = r; pos = r & 8191;
      dck = p.out + OUT_CKVP + ((size_t)o * 16384 + r) * 256;
      dkr = p.out + OUT_KRP + ((size_t)o * 16384 + r) * 64;
    } else {
      const int rr = r - M_PROMPT, b = rr >> 5, s = rr & 31;
      kvrow = (size_t)M_PROMPT + b * KSTR_S + 1024 + s; pos = 1024 + s;
      dck = p.out + OUT_CKVS + ((size_t)o * 512 + rr) * 256;
      dkr = p.out + OUT_KRS + ((size_t)o * 512 + rr) * 64;
    }
    const float4 w4 = *(const float4*)(kvw + lane * 4);
    const float c0 = kv.x * rk * w4.x, c1 = kv.y * rk * w4.y, c2 = kv.z * rk * w4.z, c3 = kv.w * rk * w4.w;
    *(float4*)(dck + lane * 4) = make_float4(c0, c1, c2, c3);
    st_bf4(ckvb + kvrow * 256 + lane * 4, c0, c1, c2, c3);
    const float other = __shfl_xor(kr, 32, 64);
    const float2 cs = rope[pos * 32 + (lane & 31)];
    const float ro = lane < 32 ? kr * cs.x - other * cs.y : kr * cs.x + other * cs.y;
    dkr[lane] = ro;
    krb[kvrow * 64 + lane] = f2bf(ro);
  }
  const int gt = get_bid() * 256 + tid, gs = gridDim.x * 256;
  const float* cck = p.cache_ckv + (size_t)o * 16 * 1024 * 256;
  const float* ckr = p.cache_krope + (size_t)o * 16 * 1024 * 64;
  for (int idx = gt; idx < 524288; idx += gs) {
    const int b = idx >> 15, rem = idx & 32767, k = rem >> 5, c8 = (rem & 31) * 8;
    const float* s = cck + ((size_t)(b * 1024 + k)) * 256 + c8;
    const float4 a0 = *(const float4*)s, a1 = *(const float4*)(s + 4);
    *(uint4*)(ckvb + ((size_t)M_PROMPT + b * KSTR_S + k) * 256 + c8) = make_uint4(pk2(a0.x, a0.y), pk2(a0.z, a0.w), pk2(a1.x, a1.y), pk2(a1.z, a1.w));
  }
  for (int idx = gt; idx < 131072; idx += gs) {
    const int b = idx >> 13, rem = idx & 8191, k = rem >> 3, c8 = (rem & 7) * 8;
    const float* s = ckr + ((size_t)(b * 1024 + k)) * 64 + c8;
    const float4 a0 = *(const float4*)s, a1 = *(const float4*)(s + 4);
    *(uint4*)(krb + ((size_t)M_PROMPT + b * KSTR_S + k) * 64 + c8) = make_uint4(pk2(a0.x, a0.y), pk2(a0.z, a0.w), pk2(a1.x, a1.y), pk2(a1.z, a1.w));
  }
  const unsigned zu = __float_as_uint(zero_f());
  for (int idx = gt; idx < 16 * 96 * 32; idx += gs) {
    const int b = idx / 3072, rem = idx % 3072, k = 1056 + (rem >> 5), c8 = (rem & 31) * 8;
    *(uint4*)(ckvb + ((size_t)M_PROMPT + b * KSTR_S + k) * 256 + c8) = make_uint4(zu, zu, zu, zu);
  }
  for (int idx = gt; idx < 16 * 96 * 8; idx += gs) {
    const int b = idx / 768, rem = idx % 768, k = 1056 + (rem >> 3), c8 = (rem & 7) * 8;
    *(uint4*)(krb + ((size_t)M_PROMPT + b * KSTR_S + k) * 64 + c8) = make_uint4(zu, zu, zu, zu);
  }
}

DI void attn_item(const u16* __restrict__ qbuf, const u16* __restrict__ knope, const u16* __restrict__ krope,
                  const u16* __restrict__ vt, long vt_ld, u16* __restrict__ ao, int head, int qrow0, int nwaves,
                  long kvrow0, int ntiles, int tiles_lo, int nkeys, char* smem, bool dry) {
  const int tid = get_tid();
  const int lane = tid & 63, wave = tid >> 6;
  const int l31 = lane & 31, h2 = lane >> 5;
  const bool active = wave < nwaves;
  const int my_tiles = wave < 2 ? tiles_lo : ntiles;
  const int qrow = qrow0 + wave * 32 + l31;
  const int rsw = (l31 >> 1) & 7;
  int koff[4];
#pragma unroll
  for (int c4 = 0; c4 < 4; ++c4) koff[c4] = l31 * 128 + (((2 * c4 + h2) ^ rsw) << 4);
  bf16x8 qf[12];
  if (active) {
    const u16* qp = qbuf + (size_t)qrow * 1536 + head * 192 + h2 * 8;
#pragma unroll
    for (int ks = 0; ks < 12; ++ks) qf[ks] = *(const bf16x8*)(qp + ks * 16);
  } else {
#pragma unroll
    for (int ks = 0; ks < 12; ++ks) qf[ks] = (bf16x8){0, 0, 0, 0, 0, 0, 0, 0};
  }
  f32x16 oacc[4];
  { const float z = zero_f();
#pragma unroll
  for (int i = 0; i < 4; ++i)
#pragma unroll
    for (int j = 0; j < 16; ++j) oacc[i][j] = z; }
  float m_run = -INFINITY, l_run = 0.f;

  const int wu = __builtin_amdgcn_readfirstlane(wave);
  const unsigned sbase = (unsigned)__builtin_amdgcn_readfirstlane((int)(unsigned)(size_t)smem);
  const int r8 = lane >> 3, c0 = (lane & 7) ^ (r8 >> 1);
  const unsigned ce = (unsigned)(c0 << 3), co = (unsigned)((c0 ^ 4) << 3);
  unsigned ko = (unsigned)((kvrow0 + (wu & 1) * 32 + r8) * 1024 + head * 128 + (wu >> 1) * 64);
  unsigned ro = (unsigned)((kvrow0 + wu * 16 + r8) * 64);
  unsigned vo = (unsigned)((head * 128 + wu * 32 + r8) * vt_ld);
  const unsigned vld8 = (unsigned)vt_ld * 8u;
  const unsigned kdst = sbase + (wu >> 1) * 8192 + (wu & 1) * 4096;
  const unsigned rdst = sbase + 16384 + wu * 2048;
  const unsigned vdst = sbase + 24576 + wu * 4096;
#define ATT_DMA(BUFOFF)                                                                                        \
  {                                                                                                            \
    _Pragma("unroll") for (int i = 0; i < 4; ++i) dma16(knope + (ko + (unsigned)i * 8192u + ((i & 1) ? co : ce)), kdst + (BUFOFF) + i * 1024); \
    _Pragma("unroll") for (int i = 0; i < 2; ++i) dma16(krope + (ro + (unsigned)i * 512u + ((i & 1) ? co : ce)), rdst + (BUFOFF) + i * 1024);   \
    _Pragma("unroll") for (int i = 0; i < 4; ++i) dma16(vt + (vo + (unsigned)i * vld8 + ((i & 1) ? co : ce)), vdst + (BUFOFF) + i * 1024);      \
    ko += 65536u; ro += 4096u; vo += 64u;                                                                      \
  }
  __syncthreads();
  ATT_DMA(0u)
  for (int kt = 0; kt < ntiles; ++kt) {
    asm volatile("s_waitcnt vmcnt(0)" ::: "memory");
    __syncthreads();
    if (kt + 1 < ntiles) ATT_DMA((unsigned)((kt + 1) & 1) * 40960u)
    if (active && kt < my_tiles) {
      const char* cur = smem + (kt & 1) * 40960;
      f32x16 st[2];
#pragma unroll
      for (int mt = 0; mt < 2; ++mt) {
#pragma unroll
        for (int j = 0; j < 16; ++j) st[mt][j] = 0.f;
#pragma unroll
        for (int ks = 0; ks < 12; ++ks) {
          const bf16x8 kf = *(const bf16x8*)(cur + koff[ks & 3] + (ks >> 2) * 8192 + mt * 4096);
          st[mt] = __builtin_amdgcn_mfma_f32_32x32x16_bf16(kf, qf[ks], st[mt], 0, 0, 0);
        }
      }
      if (kt * 64 + 64 > nkeys) {
#pragma unroll
        for (int mt = 0; mt < 2; ++mt)
#pragma unroll
          for (int j = 0; j < 16; ++j) {
            const int key = kt * 64 + mt * 32 + (j & 3) + 8 * (j >> 2) + 4 * h2;
            if (key >= nkeys) st[mt][j] = -INFINITY;
          }
      }
      float mx = fmaxf(st[0][0], st[1][0]);
#pragma unroll
      for (int j = 1; j < 16; ++j) mx = fmaxf(mx, fmaxf(st[0][j], st[1][j]));
      mx = fmaxf(mx, __shfl_xor(mx, 32, 64));
      const float m_new = fmaxf(m_run, mx);
      const float alpha = __builtin_amdgcn_exp2f(m_run - m_new);
      m_run = m_new;
      float ps = 0.f;
#pragma unroll
      for (int mt = 0; mt < 2; ++mt)
#pragma unroll
        for (int j = 0; j < 16; ++j) { const float pv = __builtin_amdgcn_exp2f(st[mt][j] - m_new); st[mt][j] = pv; ps += pv; }
      l_run = l_run * alpha + ps;
      if (__any(alpha != 1.f)) {
#pragma unroll
        for (int i = 0; i < 4; ++i)
#pragma unroll
          for (int j = 0; j < 16; ++j) oacc[i][j] *= alpha;
      }
#pragma unroll
      for (int mt = 0; mt < 2; ++mt)
#pragma unroll
        for (int s = 0; s < 2; ++s) {
          union { bf16x8 v; unsigned u[4]; } pf;
#pragma unroll
          for (int k = 0; k < 4; ++k) pf.u[k] = pk2(st[mt][8 * s + 2 * k], st[mt][8 * s + 2 * k + 1]);
#pragma unroll
          for (int vt4 = 0; vt4 < 4; ++vt4) {
            const bf16x8 vf = *(const bf16x8*)(cur + 24576 + koff[mt * 2 + s] + vt4 * 4096);
            oacc[vt4] = __builtin_amdgcn_mfma_f32_32x32x16_bf16(vf, pf.v, oacc[vt4], 0, 0, 0);
          }
        }
    }
  }
#undef ATT_DMA
  const float lt_probe = l_run + oacc[0][0] + oacc[1][5] + oacc[2][9] + oacc[3][15];
  if (active && (!dry || lt_probe == 123456.789f)) {
    const float lt = l_run + __shfl_xor(l_run, 32, 64);
    const float inv = 1.f / lt;
    u16* op = ao + (size_t)qrow * 1024 + head * 128 + 4 * h2;
#pragma unroll
    for (int vt4 = 0; vt4 < 4; ++vt4)
#pragma unroll
      for (int a = 0; a < 4; ++a) {
        u16* q = op + vt4 * 32 + 8 * a;
        const uint2 gt = *(const uint2*)q;
        st_bf4(q, oacc[vt4][4 * a] * inv * bflo(gt.x), oacc[vt4][4 * a + 1] * inv * bfhi(gt.x),
               oacc[vt4][4 * a + 2] * inv * bflo(gt.y), oacc[vt4][4 * a + 3] * inv * bfhi(gt.y));
      }
  }
}

DI void attn_phase(const Params& p, char* smem, bool dry) {
  const u16* qbuf = (const u16*)(p.ws + OFF_ZQ);
  const u16* knope = (const u16*)(p.ws + OFF_KN);
  const u16* krb = (const u16*)(p.ws + OFFB_KROPEB);
  const u16* vtb = (const u16*)(p.ws + OFF_VTO);
  u16* ao = (u16*)(p.ws + OFF_GO);
  for (int it = get_bid(); it < 640; it += gridDim.x) {
    if (it < 512) {
      const int bh = (it & 7) * 2 + ((it >> 3) & 1), qp = it >> 4;
      const int b = bh >> 3, h = bh & 7;
      const u16* vt = vtb + (size_t)b * 1024 * 8192;
#pragma unroll 1
      for (int half = 0; half < 2; ++half) {
        const int qb = half == 0 ? 63 - qp : qp;
        attn_item(qbuf, knope, krb, vt, 8192, ao, h, b * 8192 + qb * 128, 4, (long)b * 8192, 2 * qb + 2, 2 * qb + 1,
                  (2 * qb + 2) * 64, smem, dry);
      }
    } else {
      const int s = it - 512, b = s >> 3, h = s & 7;
      const u16* vt = vtb + (size_t)2 * 1024 * 8192 + (size_t)b * 1024 * KSTR_S;
      attn_item(qbuf, knope, krb, vt, KSTR_S, ao, h, M_PROMPT + b * 32, 1, (long)M_PROMPT + (long)b * KSTR_S, 17, 17, 1056, smem, dry);
    }
  }
  __syncthreads();
  if (get_tid() == 0) { const unsigned zu = __float_as_uint(zero_f()); *(uint4*)(smem + 81904) = make_uint4(zu, zu, zu, zu); }
}

#define XB_TMO      128
#define XB_XCNT(j)  (256  + 64 * (j))
#define XB_XSUB(j)  (1280 + 64 * (j))
#define XB_XGEN(j)  (2304 + 64 * (j))
#define XB_TOP      3328
#define XB_TOPGEN   3392
#define XCD_BAR_WORDS 3456
#define XB_SPIN_CAP (1u << 20)
#define LAS __attribute__((address_space(3)))
constexpr size_t OFFB_BAR = 16000000;

DI unsigned xb_ld(unsigned* p) { return __hip_atomic_load(p, __ATOMIC_RELAXED, __HIP_MEMORY_SCOPE_AGENT); }
DI unsigned xb_add(unsigned* p, unsigned v) { return __hip_atomic_fetch_add(p, v, __ATOMIC_RELAXED, __HIP_MEMORY_SCOPE_AGENT); }
DI unsigned xb_xcc_id() { return (unsigned)__builtin_amdgcn_s_getreg((3 << 11) | 20) & 0xFu; }
#define XB_SPIN(cond, bar) do { unsigned _sp = 0; while (cond) { __builtin_amdgcn_s_sleep(1); \
    if ((++_sp & 255u) == 0u) { if (xb_ld(&(bar)[XB_TMO])) break; if (_sp > XB_SPIN_CAP) { atomicAdd(&(bar)[XB_TMO], 1u); break; } } } } while (0)

struct XcdBarrier { unsigned* bar; unsigned x; volatile LAS unsigned* st; };

DI XcdBarrier xcd_barrier_post(unsigned* bar, volatile LAS unsigned* st) {
  XcdBarrier b; b.bar = bar; b.x = xb_xcc_id(); b.st = st;
  if (threadIdx.x == 0) (void)xb_add(&bar[XB_XCNT(b.x)], 1u);
  return b;
}
DI void xcd_barrier_complete(unsigned* bar, unsigned x, unsigned& nloc, unsigned& nx) {
  const unsigned G = gridDim.x * gridDim.y * gridDim.z;
  unsigned sum, cnt, mine, sp = 0u;
  for (;;) {
    sum = 0u; cnt = 0u; mine = 0u;
#pragma unroll
    for (unsigned j = 0; j < 16; ++j) { const unsigned c = xb_ld(&bar[XB_XCNT(j)]); sum += c; cnt += (c > 0u) ? 1u : 0u; mine = (j == x) ? c : mine; }
    if (sum == G) break;
    __builtin_amdgcn_s_sleep(1);
    if ((++sp & 255u) == 0u) { if (xb_ld(&bar[XB_TMO])) break; if (sp > XB_SPIN_CAP) { atomicAdd(&bar[XB_TMO], 1u); break; } }
  }
  nloc = mine > 0u ? mine : 1u; nx = cnt > 0u ? cnt : 1u;
}
DI void xcd_barrier(const XcdBarrier& b) {
  asm volatile("s_waitcnt vmcnt(0)" ::: "memory");
  __syncthreads();
  if (threadIdx.x == 0) {
    unsigned* bar = b.bar;
    __builtin_amdgcn_s_waitcnt(0);
    unsigned nloc = b.st[0], nx = b.st[1];
    if (nloc == 0u) { xcd_barrier_complete(bar, b.x, nloc, nx); b.st[0] = nloc; b.st[1] = nx; }
    const unsigned old = xb_add(&bar[XB_XSUB(b.x)], 1u);
    const unsigned gen = old / nloc;
    if (old + 1u == (gen + 1u) * nloc) {
      __builtin_amdgcn_fence(__ATOMIC_RELEASE, "agent");
      asm volatile("s_waitcnt vmcnt(0)" ::: "memory");
      const unsigned og = xb_add(&bar[XB_TOP], 1u);
      const unsigned tg = og / nx;
      if (og + 1u == (tg + 1u) * nx) xb_add(&bar[XB_TOPGEN], 1u);
      else XB_SPIN(xb_ld(&bar[XB_TOPGEN]) == tg, bar);
      __builtin_amdgcn_fence(__ATOMIC_ACQUIRE, "agent");
      xb_add(&bar[XB_XGEN(b.x)], 1u);
      asm volatile("s_waitcnt vmcnt(0)" ::: "memory");
    } else {
      XB_SPIN(xb_ld(&bar[XB_XGEN(b.x)]) == gen, bar);
      __builtin_amdgcn_fence(__ATOMIC_ACQUIRE, "agent");
      asm volatile("s_waitcnt vmcnt(0)" ::: "memory");
    }
  }
  __syncthreads();
}

DI void phase_even(const Params& p, int e, int sub, char* smem) {
  const int layer = 2 * e;
  u16* W = (u16*)(p.ws + OFF_W);
  u16* hbuf = (u16*)(p.ws + OFF_H);
  u16* abuf = (u16*)(p.ws + OFF_A);
  u16* uvbuf = (u16*)(p.ws + OFF_UV);
  u16* gbuf = (u16*)(p.ws + OFF_GATE);
  u16* vT = (u16*)(p.ws + OFF_VTE);
  if (sub == 0) {
    EpiE1 epi{abuf, uvbuf, gbuf, p.out + OUT_SPP + (size_t)e * 2 * 15 * 1024, p.out + OUT_SPS + (size_t)e * 16 * 15 * 1024};
    bool pre = false;
    for (int t = get_bid(); t < 132 * 40; t += gridDim.x) {
      const int tm = t / 40, tn = t % 40;
      const int t2 = t + gridDim.x, tm2 = t2 / 40, tn2 = t2 % 40;
      const bool nx = t2 < 132 * 40;
      gemm_tile<4>(hbuf + (size_t)tm * 128 * 1024, 1024, W + WE_IN + (size_t)tn * 128 * 1024, 1024, 1024, smem, tm * 128, tn * 128, epi, pre,
                   nx ? hbuf + (size_t)tm2 * 128 * 1024 : nullptr, W + WE_IN + (size_t)tn2 * 128 * 1024);
      pre = nx;
    }
  } else if (sub == 1) {
    sgu_ln_items(p, e, smem);
    pool_d_items(p, e);
  } else if (sub == 2) {
    for (int t = get_bid(); t < 1056 + 1152; t += gridDim.x) {
      if (t < 1056) {
        const int g = t / 264, r = t % 264, tm = r >> 1, tn = r & 1;
        EpiPool epi{p.pool_scale + e * 1024, gbuf, g};
        gemm_tile<4>(hbuf + (size_t)tm * 128 * 1024 + g * 256, 1024, W + WE_POOL + (size_t)g * 65536 + (size_t)tn * 128 * 256, 256, 256, smem,
                     tm * 128, tn * 128, epi);
      } else {
        const int u = t - 1056, c = u >> 3, g = (u >> 1) & 3, tn = u & 1;
        EpiSgu epi{p.b_spatial + (e * 4 + g) * 128, uvbuf, gbuf, g, c < 128 ? c * 128 : M_PROMPT + (c - 128) * 32, c < 128 ? 128 : 32};
        gemm_tile<4>(W + WE_WS + (size_t)g * 16384, 128, vT + ((size_t)c * 1024 + g * 256 + tn * 128) * 128, 128, 128, smem, 0, tn * 128, epi);
      }
    }
  } else if (sub == 3) {
    EpiBF16 epi{(u16*)(p.ws + OFF_UV), 1024};
    for (int t = get_bid(); t < 512 + 64; t += gridDim.x) {
      if (t < 512) {
        const int tm = t >> 3, tn = t & 7;
        gemm_dma<256>(gbuf + (size_t)tm * 256 * 2048, 2048, W + WE_OUT + (size_t)tn * 128 * 2048, 2048, 2048, smem, tm * 256, tn * 128, epi);
      } else {
        const int u = t - 512, tm = u >> 3, tn = u & 7, m0 = M_PROMPT + tm * 64;
        gemm_tile<2>(gbuf + (size_t)m0 * 2048, 2048, W + WE_OUT + (size_t)tn * 128 * 2048, 2048, 2048, smem, m0, tn * 128, epi);
      }
    }
  } else {
    resid_norm(p, layer, (const u16*)(p.ws + OFF_UV));
    convert_weights(p, layer + 1, smem);
  }
}

DI void knope_tile(const Params& p, int u, char* smem) {
  const u16* W = (const u16*)(p.ws + OFF_W);
  const u16* ckvb = (const u16*)(p.ws + OFF_CKVB);
  EpiBF16 ek{(u16*)(p.ws + OFF_KN), 1024};
  const int tm = u >> 3, tn = u & 7;
  gemm_dma<256>(ckvb + (size_t)tm * 256 * 256, 256, W + WO_KV + (size_t)tn * 128 * 256, 256, 256, smem, tm * 256, tn * 128, ek);
}

DI void phase_odd(const Params& p, int o, int sub, char* smem) {
  const int layer = 2 * o + 1;
  u16* W = (u16*)(p.ws + OFF_W);
  u16* hbuf = (u16*)(p.ws + OFF_H);
  u16* ckvb = (u16*)(p.ws + OFF_CKVB);
  if (sub == 0) {
    EpiO1 epi{(float*)(p.ws + OFF_ZQ), (u16*)(p.ws + OFF_GO)};
    bool pre = false;
    for (int t = get_bid(); t < 132 * 14; t += gridDim.x) {
      const int tm = t / 14, tn = t % 14;
      const int t2 = t + gridDim.x, tm2 = t2 / 14, tn2 = t2 % 14;
      const bool nx = t2 < 132 * 14;
      gemm_tile<4>(hbuf + (size_t)tm * 128 * 1024, 1024, W + WO_IN + (size_t)tn * 128 * 1024, 1024, 1024, smem, tm * 128, tn * 128, epi, pre,
                   nx ? hbuf + (size_t)tm2 * 128 * 1024 : nullptr, W + WO_IN + (size_t)tn2 * 128 * 1024);
      pre = nx;
    }
  } else if (sub == 1) {
    odd_rows(p, o);
  } else if (sub == 2) {
    EpiQup eq{(const float2*)(p.ws + OFFB_ROPE), (u16*)(p.ws + OFF_ZQ)};
    const u16* qn = (const u16*)(p.ws + OFF_QN);
    bool pre = false;
    for (int t = get_bid(); t < 1584 + 256; t += gridDim.x) {
      if (t < 1584) {
        const int tm = t / 12, tn = t % 12;
        const int t2 = t + gridDim.x, tm2 = t2 / 12, tn2 = t2 % 12;
        const bool nx = t2 < 1584;
        gemm_tile<4>(qn + (size_t)tm * 128 * 384, 384, W + WO_Q + (size_t)tn * 128 * 384, 384, 384, smem, tm * 128, tn * 128, eq, pre,
                     nx ? qn + (size_t)tm2 * 128 * 384 : nullptr, W + WO_Q + (size_t)tn2 * 128 * 384);
        pre = nx;
      } else {
        knope_tile(p, t - 1584, smem);
      }
    }
  } else if (sub == 3) {
    u16* vtb = (u16*)(p.ws + OFF_VTO);
    for (int t = get_bid(); t < 1088 + 832; t += gridDim.x) {
      if (t < 1088) {
        int b, tm, tn; long kv0, ld; u16* C;
        if (t < 512) { b = t >> 8; const int r = t & 255; tm = r >> 6; tn = r & 63; kv0 = (long)b * 8192; ld = 8192; C = vtb + (size_t)b * 1024 * 8192; }
        else { const int u = t - 512; b = u / 36; const int r = u % 36; tm = r / 9; tn = r % 9; kv0 = (long)M_PROMPT + (long)b * KSTR_S; ld = KSTR_S;
               C = vtb + (size_t)2 * 1024 * 8192 + (size_t)b * 1024 * KSTR_S; }
        EpiVT ev{C, ld};
        gemm_dma<256>(W + WO_KV + (size_t)(1024 + tm * 256) * 256, 256, ckvb + (size_t)(kv0 + tn * 128) * 256, 256, 256, smem, tm * 256, tn * 128, ev);
      } else {
        knope_tile(p, 256 + (t - 1088), smem);
      }
    }
  } else if (sub == 4) {
#if PROBE_ATTN
    attn_phase(p, smem, true);
#endif
    attn_phase(p, smem, false);
  } else if (sub == 5) {
    EpiBF16 epi{(u16*)(p.ws + OFF_KN), 1024};
    const u16* ao = (const u16*)(p.ws + OFF_GO);
    for (int t = get_bid(); t < 512 + 64; t += gridDim.x) {
      if (t < 512) {
        const int tm = t >> 3, tn = t & 7;
        gemm_dma<256>(ao + (size_t)tm * 256 * 1024, 1024, W + WO_O + (size_t)tn * 128 * 1024, 1024, 1024, smem, tm * 256, tn * 128, epi);
      } else {
        const int u = t - 512, tm = u >> 3, tn = u & 7, m0 = M_PROMPT + tm * 64;
        gemm_tile<2>(ao + (size_t)m0 * 1024, 1024, W + WO_O + (size_t)tn * 128 * 1024, 1024, 1024, smem, m0, tn * 128, epi);
      }
    }
  } else {
    resid_norm(p, layer, (const u16*)(p.ws + OFF_KN));
    if (layer < 3) convert_weights(p, layer + 1, smem);
  }
}

DI void run_phase(const Params& p, int ph, char* smem) {
  if (ph == 0) { convert_weights(p, 0, smem); prenorm0(p); }
  else if (ph <= 5) phase_even(p, 0, ph - 1, smem);
  else if (ph <= 12) phase_odd(p, 0, ph - 6, smem);
  else if (ph <= 17) phase_even(p, 1, ph - 13, smem);
  else phase_odd(p, 1, ph - 18, smem);
}

#if !USE_COOP
__global__ void __launch_bounds__(256, 2) k_phase(Params p, int ph) {
  __shared__ __attribute__((aligned(16))) char smem[81920];
  run_phase(p, ph, smem);
}
#endif

#if USE_COOP
__global__ void __launch_bounds__(256, 2) k_mega(Params p) {
  __shared__ __attribute__((aligned(16))) char smem[81920];
  cg::grid_group grid = cg::this_grid();
  if (threadIdx.x == 0) *(uint4*)(smem + 81904) = make_uint4(0u, 0u, 0u, 0u);
  __syncthreads();
  XcdBarrier xb = xcd_barrier_post((unsigned*)(p.ws + OFFB_BAR), (volatile LAS unsigned*)(smem + 81904));
#pragma unroll 1
  for (int ph = 0; ph < NPHASE; ++ph) {
    run_phase(p, ph, smem);
    if (ph + 1 < NPHASE) xcd_barrier(xb);
    if (p.out == nullptr) grid.sync();
  }
}
#endif

extern "C" void kernel_launch(void* const* d_in, const int* in_sizes, int n_in, void* d_out, int out_size, void* d_ws,
                              size_t ws_size, hipStream_t stream) {
  (void)in_sizes; (void)n_in; (void)out_size;
  if (ws_size < 268435456ull) { fprintf(stderr, "ws too small: %zu\n", ws_size); return; }
  Params p{};
  p.x_prompt = (const float*)d_in[0]; p.x_sample = (const float*)d_in[1]; p.cache_pool = (const float*)d_in[2];
  p.cache_ckv = (const float*)d_in[3]; p.cache_krope = (const float*)d_in[4]; p.norm_pre = (const float*)d_in[5];
  p.norm_post = (const float*)d_in[6]; p.w_in_even = (const float*)d_in[7]; p.w_pool = (const float*)d_in[8];
  p.pool_scale = (const float*)d_in[9]; p.sgu_ln_g = (const float*)d_in[10]; p.sgu_ln_b = (const float*)d_in[11];
  p.w_spatial = (const float*)d_in[12]; p.b_spatial = (const float*)d_in[13]; p.w_out_even = (const float*)d_in[14];
  p.w_in_odd = (const float*)d_in[15]; p.q_norm = (const float*)d_in[16]; p.kv_norm = (const float*)d_in[17];
  p.w_q_up = (const float*)d_in[18]; p.w_kv_up = (const float*)d_in[19]; p.w_o = (const float*)d_in[20];
  p.out = (float*)d_out; p.ws = (char*)d_ws;
#if USE_COOP
  static int grid_blocks = 0;
  if (!grid_blocks) {
    int dev = 0, cus = 0, per_cu = 0;
    (void)hipGetDevice(&dev);
    (void)hipDeviceGetAttribute(&cus, hipDeviceAttributeMultiprocessorCount, dev);
    (void)hipOccupancyMaxActiveBlocksPerMultiprocessor(&per_cu, k_mega, 256, 0);
    if (per_cu > 2) per_cu = 2;
    if (per_cu < 1) per_cu = 1;
    grid_blocks = cus * per_cu;
  }
  (void)hipMemsetAsync((char*)d_ws + OFFB_BAR, 0, XCD_BAR_WORDS * 4, stream);
  void* args[] = {&p};
  hipError_t e = hipLaunchCooperativeKernel((void*)k_mega, dim3(grid_blocks), dim3(256), args, 0, stream);
  if (e != hipSuccess) fprintf(stderr, "cooperative launch failed: %s (grid %d)\n", hipGetErrorString(e), grid_blocks);
#else
  for (int ph = 0; ph < NPHASE; ++ph) hipLaunchKernelGGL(k_phase, dim3(512), dim3(256), 0, stream, p, ph);
#endif
}
```
